# Optimizing an MI355X kernel written in HIP

```python
import jax, jax.numpy as jnp
from jax import lax
import numpy as np

D_MODEL = 1024
BATCH = 4
SEQ = 4096
DEPTH = 1
DEC_BATCH = 8
DEC_SEQ = 32
PAST_LEN = 2048

CHUNK = 64
MIX_WIDTH = D_MODEL
SB_WIDTH = MIX_WIDTH // 2
SB_HEAD_DIM = 64
SB_HEADS = SB_WIDTH // SB_HEAD_DIM
POOL_WIDTH = MIX_WIDTH - SB_WIDTH
POOL_WINDOWS = (2, 4, 8, 16)
POOL_GROUPS = len(POOL_WINDOWS)
POOL_GC = POOL_WIDTH // POOL_GROUPS
POOL_HIST = max(POOL_WINDOWS) - 1
IN_WIDTH = 3 * SB_WIDTH + POOL_WIDTH
D_FF = -(-8 * D_MODEL // (3 * 256)) * 256
Q_BLOCK = 128
ALPHA = (2 * DEPTH) ** 0.25
BETA = (8 * DEPTH) ** -0.25
LN_EPS = 1e-5

kernel_name = "stickbreak_pool_hybrid_stream_step"


def _layer_norm(x, g, b):
    xf = x.astype(jnp.float32)
    mu = jnp.mean(xf, axis=-1, keepdims=True)
    var = jnp.mean(jnp.square(xf - mu), axis=-1, keepdims=True)
    return ((xf - mu) * lax.rsqrt(var + LN_EPS) * g.astype(jnp.float32) + b.astype(jnp.float32)).astype(x.dtype)


def _sb_block(qb, qpos, k, v, kpos):
    z = jnp.einsum('bqhd,bkhd->bhqk', qb.astype(jnp.float32), k.astype(jnp.float32)) * (SB_HEAD_DIM ** -0.5)
    mask = kpos[None, :] < qpos[:, None]
    log_beta = jax.nn.log_sigmoid(z)
    log_1m = jnp.where(mask, log_beta - z, 0.0)
    after = lax.cumsum(log_1m, axis=3, reverse=True) - log_1m
    a = jnp.where(mask, jnp.exp(log_beta + after), 0.0)
    return jnp.einsum('bhqk,bkhd->bqhd', a, v.astype(jnp.float32))


def _stick_breaking(q, k, v, q_start):
    B, T, H, dh = q.shape
    qbs = min(Q_BLOCK, T)
    nblk = T // qbs
    qpos = q_start + jnp.arange(T, dtype=jnp.int32)
    kpos = jnp.arange(k.shape[1], dtype=jnp.int32)
    qs = q.reshape(B, nblk, qbs, H, dh).transpose(1, 0, 2, 3, 4)
    ps = qpos.reshape(nblk, qbs)
    out = lax.map(lambda a: _sb_block(a[0], a[1], k, v, kpos), (qs, ps))
    return out.transpose(1, 0, 2, 3, 4).reshape(B, T, H * dh)


def _pool_mix(u, hist, start_pos, pool_w, pool_scale):
    B, T, C = u.shape
    ue = jnp.concatenate([hist.astype(jnp.float32), u.astype(jnp.float32)], axis=1)
    csum = jnp.concatenate([jnp.zeros((B, 1, C), jnp.float32), jnp.cumsum(ue, axis=1)], axis=1)
    pos = start_pos + jnp.arange(T, dtype=jnp.int32)
    P = POOL_HIST
    diffs = []
    for g, w in enumerate(POOL_WINDOWS):
        lo_c, hi_c = g * POOL_GC, (g + 1) * POOL_GC
        hi = csum[:, P + 1:P + 1 + T, lo_c:hi_c]
        lo = csum[:, P + 1 - w:P + 1 - w + T, lo_c:hi_c]
        cnt = jnp.minimum(w, pos + 1).astype(jnp.float32)[None, :, None]
        diffs.append((hi - lo) / cnt - ue[:, P:, lo_c:hi_c])
    d = jnp.stack(diffs, axis=2)
    y = jnp.einsum('btgc,gcd->btgd', d, pool_w.astype(jnp.float32)).reshape(B, T, C)
    y = y * pool_scale.astype(jnp.float32)
    return y.astype(u.dtype), ue[:, -P:].astype(u.dtype)


def _layer(x, k_hist, v_hist, pool_hist, start_pos, w_in, pool_w, pool_scale, w_out,
           ln1_g, ln1_b, w_gate, w_up, w_down, ln2_g, ln2_b):
    B, T, _ = x.shape
    h = x @ w_in
    q = h[..., :SB_WIDTH].reshape(B, T, SB_HEADS, SB_HEAD_DIM)
    k = h[..., SB_WIDTH:2 * SB_WIDTH].reshape(B, T, SB_HEADS, SB_HEAD_DIM)
    v = h[..., 2 * SB_WIDTH:3 * SB_WIDTH].reshape(B, T, SB_HEADS, SB_HEAD_DIM)
    u = h[..., 3 * SB_WIDTH:]
    k_all = jnp.concatenate([k_hist.astype(k.dtype), k], axis=1)
    v_all = jnp.concatenate([v_hist.astype(v.dtype), v], axis=1)
    a_out = _stick_breaking(q, k_all, v_all, start_pos).astype(x.dtype)
    p_out, new_pool = _pool_mix(u, pool_hist, start_pos, pool_w, pool_scale)
    mix = jnp.concatenate([a_out, p_out], axis=-1) @ w_out
    x1 = _layer_norm(ALPHA * x + mix, ln1_g, ln1_b)
    ffn = (jax.nn.silu(x1 @ w_gate) * (x1 @ w_up)) @ w_down
    y = _layer_norm(ALPHA * x1 + ffn, ln2_g, ln2_b)
    return y, k, v, new_pool


def setup_inputs(seed: int = 0) -> dict:
    key = jax.random.key(seed)
    ks = jax.random.split(key, 16)
    f32 = jnp.float32
    nrm = lambda k_, s: jax.random.normal(k_, s, f32)
    col_scale = jnp.concatenate([jnp.ones((2 * SB_WIDTH,), f32), jnp.full((SB_WIDTH,), BETA, f32),
                                 jnp.ones((POOL_WIDTH,), f32)])
    return {
        "x_prompt": nrm(ks[0], (BATCH, SEQ, D_MODEL)),
        "x_sample": nrm(ks[1], (DEC_BATCH, DEC_SEQ, D_MODEL)),
        "cache_k": nrm(ks[2], (DEC_BATCH, PAST_LEN, SB_HEADS, SB_HEAD_DIM)),
        "cache_v": nrm(ks[3], (DEC_BATCH, PAST_LEN, SB_HEADS, SB_HEAD_DIM)) * BETA,
        "state_pool": nrm(ks[4], (DEC_BATCH, POOL_HIST, POOL_WIDTH)),
        "w_in": nrm(ks[5], (D_MODEL, IN_WIDTH)) * (D_MODEL ** -0.5) * col_scale[None, :],
        "pool_w": nrm(ks[6], (POOL_GROUPS, POOL_GC, POOL_GC)) * (POOL_GC ** -0.5),
        "pool_scale": 1.0 + 0.02 * nrm(ks[7], (POOL_WIDTH,)),
        "w_out": nrm(ks[8], (MIX_WIDTH, D_MODEL)) * (MIX_WIDTH ** -0.5) * BETA,
        "ln1_g": 1.0 + 0.02 * nrm(ks[9], (D_MODEL,)),
        "ln1_b": 0.02 * nrm(ks[10], (D_MODEL,)),
        "w_gate": nrm(ks[11], (D_MODEL, D_FF)) * (D_MODEL ** -0.5),
        "w_up": nrm(ks[12], (D_MODEL, D_FF)) * (D_MODEL ** -0.5) * BETA,
        "w_down": nrm(ks[13], (D_FF, D_MODEL)) * (D_FF ** -0.5) * BETA,
        "ln2_g": 1.0 + 0.02 * nrm(ks[14], (D_MODEL,)),
        "ln2_b": 0.02 * nrm(ks[15], (D_MODEL,)),
    }


def reference(x_prompt, x_sample, cache_k, cache_v, state_pool, w_in, pool_w, pool_scale, w_out,
              ln1_g, ln1_b, w_gate, w_up, w_down, ln2_g, ln2_b):
    Bp = x_prompt.shape[0]
    yp = x_prompt
    ys = x_sample
    for _ in range(DEPTH):
        k_hist0 = jnp.zeros((Bp, 0, SB_HEADS, SB_HEAD_DIM), x_prompt.dtype)
        pool_hist0 = jnp.zeros((Bp, POOL_HIST, POOL_WIDTH), x_prompt.dtype)
        yp, k_p, v_p, pool_p = _layer(yp, k_hist0, k_hist0, pool_hist0, 0, w_in, pool_w, pool_scale, w_out,
                                      ln1_g, ln1_b, w_gate, w_up, w_down, ln2_g, ln2_b)
        ys, k_s, v_s, pool_s = _layer(ys, cache_k, cache_v, state_pool, cache_k.shape[1], w_in, pool_w,
                                      pool_scale, w_out, ln1_g, ln1_b, w_gate, w_up, w_down, ln2_g, ln2_b)
    return (yp, ys, k_p, v_p, pool_p, k_s, v_s, pool_s)
```

```cpp
#include <hip/hip_runtime.h>
#include <hip/hip_cooperative_groups.h>
#include <cstdio>
namespace cg = cooperative_groups;

#ifndef MULTI_LAUNCH
#define MULTI_LAUNCH 0
#endif

#define LAS __attribute__((address_space(3)))
typedef unsigned short bf16_t;
typedef short bf16x8 __attribute__((ext_vector_type(8)));
typedef float f32x4 __attribute__((ext_vector_type(4)));
typedef unsigned u32x2 __attribute__((ext_vector_type(2)));
typedef unsigned u32x4 __attribute__((ext_vector_type(4)));

constexpr int MP = 16384, MS = 256, MT = MP + MS;
constexpr int DM = 1024, NIN = 2048, DFF = 2816, NGU = 2 * DFF;
constexpr int SEQ = 4096, DSEQ = 32, PAST = 2048;
constexpr float ALPHA = 1.189207115002721f;
constexpr float LN_EPS = 1e-5f;
constexpr float R_EXIT = 130.0f;

constexpr size_t OFF_YP = 0, OFF_YS = 16777216, OFF_KP = 17039360, OFF_VP = 25427968, OFF_PP = 33816576,
                 OFF_KS = 33847296, OFF_VS = 33978368, OFF_PS = 34109440;

constexpr size_t WS_WIN = 0;
constexpr size_t WS_WOUT = WS_WIN + (size_t)NIN * DM * 2;
constexpr size_t WS_WGU = WS_WOUT + (size_t)DM * DM * 2;
constexpr size_t WS_WD = WS_WGU + (size_t)NGU * DM * 2;
constexpr size_t WS_PWT = WS_WD + (size_t)DM * DFF * 2;
constexpr size_t WS_CS = WS_PWT + 4 * 128 * 128 * 2;
constexpr size_t WS_BW = WS_CS + (size_t)NGU * 4;
constexpr size_t WS_ST1 = WS_BW + (size_t)NGU * 4;
constexpr size_t WS_ST2 = WS_ST1 + (size_t)MT * 2 * 4;
constexpr size_t WS_BAR = WS_ST2 + (size_t)MT * 2 * 4;
constexpr size_t WS_BAR_BYTES = 36864;
constexpr size_t WS_A = 24117248;
constexpr size_t WS_B = WS_A + (size_t)MT * DFF * 2;
constexpr size_t WS_UB = WS_B + (size_t)MT * 1536 * 2;
constexpr size_t WS_C = WS_UB + (size_t)MT * 512 * 4;
constexpr size_t WS_END = WS_C + (size_t)MT * DM * 2;
static_assert(WS_BAR + WS_BAR_BYTES <= WS_A, "ws map");
static_assert(WS_END <= 268435456ull, "ws map");

struct Params {
    const float *xp, *xs, *ck, *cv, *sp, *w_in, *pool_w, *pool_scale, *w_out, *ln1g, *ln1b, *wg, *wu, *wd, *ln2g, *ln2b;
    float* out; unsigned char* ws; int ph_lo, ph_hi;
};

__device__ __forceinline__ unsigned pk_bf16(float lo, float hi) { unsigned r; asm("v_cvt_pk_bf16_f32 %0, %1, %2" : "=v"(r) : "v"(lo), "v"(hi)); return r; }
__device__ __forceinline__ bf16_t f2bf(float f) { unsigned u = __float_as_uint(f); u += 0x7FFFu + ((u >> 16) & 1u); return (bf16_t)(u >> 16); }
__device__ __forceinline__ float bf2f(bf16_t b) { return __uint_as_float(((unsigned)b) << 16); }
__device__ __forceinline__ f32x4 up4(u32x2 w) { f32x4 v; v[0] = __uint_as_float(w.x << 16); v[1] = __uint_as_float(w.x & 0xffff0000u); v[2] = __uint_as_float(w.y << 16); v[3] = __uint_as_float(w.y & 0xffff0000u); return v; }
__device__ __forceinline__ u32x2 pk4(f32x4 v) { u32x2 o; o.x = pk_bf16(v[0], v[1]); o.y = pk_bf16(v[2], v[3]); return o; }


#define XB_TMO      128
#define XB_XCNT(j)  (256  + 64 * (j))
#define XB_XSUB(j)  (1280 + 64 * (j))
#define XB_XGEN(j)  (2304 + 64 * (j))
#define XB_TOP      3328
#define XB_TOPGEN   3392
#define XCD_BAR_WORDS 3456
#define XB_SPIN_CAP (1u << 22)
__device__ __forceinline__ unsigned xb_ld(unsigned* p)              { return __hip_atomic_load(p, __ATOMIC_RELAXED, __HIP_MEMORY_SCOPE_AGENT); }
__device__ __forceinline__ unsigned xb_add(unsigned* p, unsigned v) { return __hip_atomic_fetch_add(p, v, __ATOMIC_RELAXED, __HIP_MEMORY_SCOPE_AGENT); }
__device__ __forceinline__ unsigned xb_xcc_id() { return (unsigned)__builtin_amdgcn_s_getreg((3 << 11) | 20) & 0xFu; }
#define XB_SPIN(cond, bar) do { unsigned _sp = 0; while (cond) { __builtin_amdgcn_s_sleep(1); \
    if ((++_sp & 255u) == 0u) { if (xb_ld(&(bar)[XB_TMO])) break; if (_sp > XB_SPIN_CAP) { atomicAdd(&(bar)[XB_TMO], 1u); break; } } } } while (0)
struct XcdBarrier { unsigned* bar; unsigned x; volatile LAS unsigned* st; };
__device__ __forceinline__ XcdBarrier xcd_barrier_post(unsigned* bar, volatile LAS unsigned* st) {
    XcdBarrier b; b.bar = bar; b.x = xb_xcc_id(); b.st = st;
    if (threadIdx.x == 0) (void)xb_add(&bar[XB_XCNT(b.x)], 1u);
    return b;
}
__device__ __forceinline__ void xcd_barrier_complete(unsigned* bar, unsigned x, unsigned& nloc, unsigned& nx) {
    const unsigned G = gridDim.x * gridDim.y * gridDim.z;
    unsigned sum, cnt, mine, sp = 0u;
    for (;;) {
        sum = 0u; cnt = 0u; mine = 0u;
#pragma unroll
        for (unsigned j = 0; j < 16; ++j) { const unsigned c = xb_ld(&bar[XB_XCNT(j)]); sum += c; cnt += (c > 0u) ? 1u : 0u; mine = (j == x) ? c : mine; }
        if (sum == G) break;
        __builtin_amdgcn_s_sleep(1);
        if ((++sp & 255u) == 0u) { if (xb_ld(&bar[XB_TMO])) break; if (sp > XB_SPIN_CAP) { atomicAdd(&bar[XB_TMO], 1u); break; } }
    }
    nloc = mine > 0u ? mine : 1u; nx = cnt > 0u ? cnt : 1u;
}
__device__ __forceinline__ void xcd_barrier(const XcdBarrier& b) {
    asm volatile("s_waitcnt vmcnt(0)" ::: "memory");
    __syncthreads();
    if (threadIdx.x == 0) {
        unsigned* bar = b.bar;
        __builtin_amdgcn_s_waitcnt(0);
        unsigned nloc = b.st[0], nx = b.st[1];
        if (nloc == 0u) { xcd_barrier_complete(bar, b.x, nloc, nx); b.st[0] = nloc; b.st[1] = nx; }
        const unsigned old = xb_add(&bar[XB_XSUB(b.x)], 1u);
        const unsigned gen = old / nloc;
        if (old + 1u == (gen + 1u) * nloc) {
            __builtin_amdgcn_fence(__ATOMIC_RELEASE, "agent");
            asm volatile("s_waitcnt vmcnt(0)" ::: "memory");
            const unsigned og = xb_add(&bar[XB_TOP], 1u);
            const unsigned tg = og / nx;
            if (og + 1u == (tg + 1u) * nx) xb_add(&bar[XB_TOPGEN], 1u);
            else XB_SPIN(xb_ld(&bar[XB_TOPGEN]) == tg, bar);
            __builtin_amdgcn_fence(__ATOMIC_ACQUIRE, "agent");
            xb_add(&bar[XB_XGEN(b.x)], 1u);
            asm volatile("s_waitcnt vmcnt(0)" ::: "memory");
        } else {
            XB_SPIN(xb_ld(&bar[XB_XGEN(b.x)]) == gen, bar);
            __builtin_amdgcn_fence(__ATOMIC_ACQUIRE, "agent");
            asm volatile("s_waitcnt vmcnt(0)" ::: "memory");
        }
    }
    __syncthreads();
}

namespace pg8 {
constexpr int BM = 256, BK = 64, HALF = 128, HTB = HALF * BK * 2, STAGE_BYTES = 8 * HTB, NXCD = 8, WGM = 8;
__device__ __forceinline__ int lds_byte(int r, int c) { const int st = (r >> 4) * 2 + (c >> 5), rr = r & 15, cc = c & 31, ob = rr * 64 + cc * 2; return st * 1024 + (ob ^ (((ob >> 9) & 1) << 5)); }
__device__ __forceinline__ void stage_rc(int b, int& R, int& C) { const int st = b / 1024, sb = b % 1024, swz = sb ^ (((sb >> 9) & 1) << 5); R = (st >> 1) * 16 + swz / 64; C = (st & 1) * 32 + (swz % 64) / 2; }
struct Unit { int pm, pn; };
struct Gemm { const bf16_t* A; const bf16_t* Bt; int M, N, K; };
struct StaticOrder {
    int nM, nN, nwg, G, c;
    __device__ void init(int M, int N, int G_, int c_) { nM = M / BM; nN = N / BM; nwg = nM * nN; G = G_; c = c_; }
    __device__ bool next(int i, Unit& u) const {
        const long L = (long)i * G + c; if (L >= nwg) return false;
        int wgid = (int)L; { const int q = nwg / NXCD, r = nwg % NXCD, xcd = wgid % NXCD, off = wgid / NXCD; wgid = (xcd < r ? xcd * (q + 1) : r * (q + 1) + (xcd - r) * q) + off; }
        const int nig = WGM * nN, gid = wgid / nig, fm = gid * WGM, gsz = (nM - fm) < WGM ? (nM - fm) : WGM;
        u.pm = fm + ((wgid % nig) % gsz); u.pn = (wgid % nig) / gsz; return true;
    }
};

template <class Epi>
__device__ __forceinline__ void gemm_phase(LAS unsigned char* lds, const Gemm g, const StaticOrder& S, const Epi& E) {
    const int tid = threadIdx.x, wid = __builtin_amdgcn_readfirstlane(tid >> 6), lane = tid & 63, wr = wid >> 2, wc = wid & 3, fr = lane & 15, fq = lane >> 4;
    int K_ = g.K; asm volatile("" : "+s"(K_));
    const int K = K_, nt = K / BK;
    unsigned voffA[2];
#pragma unroll
    for (int i = 0; i < 2; ++i) { int R, C; stage_rc(tid * 16 + i * 8192, R, C); voffA[i] = (unsigned)(R * K + C) * 2u; }
    const size_t kstep = (size_t)(BK * 2);
    const size_t hstep = (size_t)HALF * K * 2;
    const size_t tstep = 2 * hstep;
    const unsigned ldsw = (unsigned)wid * 1024u;
    const int aoff = lds_byte(wr * 64 + fr, fq * 8), boff = lds_byte(wc * 32 + fr, fq * 8);
#define PG8_SA(b, h) (((b) * 2 + (h)) * HTB)
#define PG8_SB(b, h) ((4 + (b) * 2 + (h)) * HTB)
#define PG8_STAGE(bufoff, gbase, voff) do { _Pragma("unroll") for (int _i = 0; _i < 2; ++_i) \
        __builtin_amdgcn_global_load_lds((const unsigned*)((const char*)(gbase) + (voff)[_i]), (LAS unsigned*)(lds + (bufoff) + ldsw + _i * 8192), 16, 0, 0); } while (0)
#define PG8_LDA(dst, b, h) do { _Pragma("unroll") for (int m = 0; m < 4; ++m) _Pragma("unroll") for (int k = 0; k < 2; ++k) dst[m][k] = *(const LAS bf16x8*)(lds + PG8_SA(b, h) + aoff + m * 2048 + k * 1024); } while (0)
#define PG8_LDB(dst, b, h) do { _Pragma("unroll") for (int n = 0; n < 2; ++n) _Pragma("unroll") for (int k = 0; k < 2; ++k) dst[n][k] = *(const LAS bf16x8*)(lds + PG8_SB(b, h) + boff + n * 2048 + k * 1024); } while (0)
#define PG8_MMA(ai, bj, At, Bt) do { __builtin_amdgcn_s_setprio(1); _Pragma("unroll") for (int m = 0; m < 4; ++m) _Pragma("unroll") for (int n = 0; n < 2; ++n) _Pragma("unroll") for (int k = 0; k < 2; ++k) \
        acc[ai][bj][m][n] = __builtin_amdgcn_mfma_f32_16x16x32_bf16(Bt[n][k], At[m][k], acc[ai][bj][m][n], 0, 0, 0); __builtin_amdgcn_s_setprio(0); } while (0)
#define PG8_WAIT_V(n) asm volatile("s_waitcnt vmcnt(" #n ")" ::: "memory")
#define PG8_WAIT_L(n) asm volatile("s_waitcnt lgkmcnt(" #n ")" ::: "memory")
#define PG8_BAR __builtin_amdgcn_s_barrier()
#define PG8_SCHED __builtin_amdgcn_sched_barrier(0)
    Unit cur, nxt; int ui = 0;
    if (!S.next(0, cur)) return;
    f32x4 acc[2][2][4][2];
#pragma unroll
    for (int a = 0; a < 2; ++a)
#pragma unroll
        for (int b = 0; b < 2; ++b)
#pragma unroll
            for (int m = 0; m < 4; ++m)
#pragma unroll
                for (int n = 0; n < 2; ++n) acc[a][b][m][n] = (f32x4){0.f, 0.f, 0.f, 0.f};
    bf16x8 At[4][2], B0[2][2], B1[2][2];
    const char* cA = (const char*)g.A + (size_t)cur.pm * tstep; const char* cB = (const char*)g.Bt + (size_t)cur.pn * tstep;
    PG8_STAGE(PG8_SB(0, 0), cB, voffA); PG8_STAGE(PG8_SA(0, 0), cA, voffA); PG8_STAGE(PG8_SB(0, 1), cB + hstep, voffA); PG8_STAGE(PG8_SA(0, 1), cA + hstep, voffA);
    if (wr == 1) PG8_BAR;
    PG8_WAIT_V(4); PG8_BAR;
    PG8_STAGE(PG8_SB(1, 0), cB + kstep, voffA); PG8_STAGE(PG8_SA(1, 0), cA + kstep, voffA); PG8_STAGE(PG8_SB(1, 1), cB + hstep + kstep, voffA);
    PG8_WAIT_V(6); PG8_BAR;
    for (;;) {
        const bool has_next = S.next(ui + 1, nxt);
        const char* nA = has_next ? (const char*)g.A + (size_t)nxt.pm * tstep : cA; const char* nB = has_next ? (const char*)g.Bt + (size_t)nxt.pn * tstep : cB;
        for (int t = 0; t < nt; t += 2) {
            const bool last = (t == nt - 2);
            const char* a1 = cA + (size_t)(t + 1) * kstep;
            const char* a2 = last ? nA : cA + (size_t)(t + 2) * kstep; const char* b2 = last ? nB : cB + (size_t)(t + 2) * kstep;
            const char* a3 = a2 + kstep; const char* b3 = b2 + kstep;
            PG8_LDB(B0, 0, 0); PG8_SCHED; PG8_LDA(At, 0, 0); PG8_STAGE(PG8_SA(1, 1), a1 + hstep, voffA);
            PG8_WAIT_L(8); PG8_BAR; PG8_WAIT_L(0); PG8_MMA(0, 0, At, B0); PG8_BAR; PG8_SCHED;
            PG8_LDB(B1, 0, 1); PG8_STAGE(PG8_SB(0, 0), b2, voffA);
            PG8_BAR; PG8_WAIT_L(0); PG8_MMA(0, 1, At, B1); PG8_BAR;
            PG8_LDA(At, 0, 1); PG8_STAGE(PG8_SA(0, 0), a2, voffA);
            PG8_BAR; PG8_WAIT_L(0); PG8_MMA(1, 0, At, B0); PG8_BAR; PG8_SCHED;
            PG8_STAGE(PG8_SB(0, 1), b2 + hstep, voffA);
            PG8_WAIT_V(6); PG8_BAR; PG8_MMA(1, 1, At, B1); PG8_BAR;
            PG8_LDB(B0, 1, 0); PG8_SCHED; PG8_LDA(At, 1, 0); PG8_STAGE(PG8_SA(0, 1), a2 + hstep, voffA);
            PG8_WAIT_L(8); PG8_BAR; PG8_WAIT_L(0); PG8_MMA(0, 0, At, B0); PG8_BAR; PG8_SCHED;
            PG8_LDB(B1, 1, 1); PG8_STAGE(PG8_SB(1, 0), b3, voffA);
            PG8_BAR; PG8_WAIT_L(0); PG8_MMA(0, 1, At, B1); PG8_BAR;
            PG8_LDA(At, 1, 1); PG8_STAGE(PG8_SA(1, 0), a3, voffA);
            PG8_BAR; PG8_WAIT_L(0); PG8_MMA(1, 0, At, B0); PG8_BAR; PG8_SCHED;
            PG8_STAGE(PG8_SB(1, 1), b3 + hstep, voffA);
            PG8_WAIT_V(6); PG8_BAR; PG8_MMA(1, 1, At, B1); PG8_BAR;
        }
        if constexpr (Epi::AFTER_DRAIN) { if (has_next) epi_main(E, acc, cur, wr, wc, fr, fq); }
        else epi_main(E, acc, cur, wr, wc, fr, fq);
        if (!has_next) break;
#pragma unroll
        for (int a = 0; a < 2; ++a)
#pragma unroll
            for (int b = 0; b < 2; ++b)
#pragma unroll
                for (int m = 0; m < 4; ++m)
#pragma unroll
                    for (int n = 0; n < 2; ++n) acc[a][b][m][n] = (f32x4){0.f, 0.f, 0.f, 0.f};
        cur = nxt; cA = nA; cB = nB; ++ui;
    }
    PG8_WAIT_V(0);
    if (wr == 0) PG8_BAR;
    PG8_BAR;
    if constexpr (Epi::AFTER_DRAIN) E.fused(acc, cur, wr, wc, fr, fq);
#undef PG8_SA
#undef PG8_SB
#undef PG8_STAGE
#undef PG8_LDA
#undef PG8_LDB
#undef PG8_MMA
#undef PG8_WAIT_V
#undef PG8_WAIT_L
#undef PG8_BAR
#undef PG8_SCHED
}
}
using pg8::Unit;

__device__ __forceinline__ void ln_stats(const float* st, int r, float& mu, float& rstd) {
    const float s = st[2 * r], q = st[2 * r + 1];
    mu = s * (1.0f / DM); const float var = q * (1.0f / DM) - mu * mu; rstd = rsqrtf(var + LN_EPS);
}
struct EpiIn {
    static constexpr bool GU = false, STATS = false, AFTER_DRAIN = false;
    bf16_t* qkvb; bf16_t* ubuf; float* out;
    struct Row {};
    __device__ __forceinline__ Row row_begin(int) const { return Row{}; }
    __device__ __forceinline__ f32x4 load(const Row&, int, int) const { return (f32x4){0.f, 0.f, 0.f, 0.f}; }
    __device__ __forceinline__ void vec(const Row&, int r, int c, f32x4 v, f32x4, float&, float&) const {
        const int seg = c >> 9;
        if (seg == 0) {
            *(u32x2*)(qkvb + (size_t)r * 1536 + c) = pk4(v * (0.125f * 1.4426950408889634f));
        } else if (seg < 3) {
            *(u32x2*)(qkvb + (size_t)r * 1536 + c) = pk4(v);
            const int isv = seg == 2; const int cc = c & 511;
            float* dst = (r < MP) ? out + (isv ? OFF_VP : OFF_KP) + (size_t)r * 512 + cc
                                  : out + (isv ? OFF_VS : OFF_KS) + (size_t)(r - MP) * 512 + cc;
            __builtin_nontemporal_store(v, (f32x4*)dst);
        } else {
            const int cc = c & 511;
            *(u32x2*)(ubuf + (size_t)r * 512 + cc) = pk4(v);
            if (r < MP) { const int t = r & (SEQ - 1), b = r >> 12; if (t >= SEQ - 15) *(f32x4*)(out + OFF_PP + (size_t)(b * 15 + t - (SEQ - 15)) * 512 + cc) = v; }
            else { const int rr = r - MP, b = rr >> 5, t = rr & 31; if (t >= DSEQ - 15) *(f32x4*)(out + OFF_PS + (size_t)(b * 15 + t - (DSEQ - 15)) * 512 + cc) = v; }
        }
    }
    __device__ __forceinline__ void row_end(int, float, float) const {}
};
struct EpiOut {
    static constexpr bool GU = false, STATS = true, AFTER_DRAIN = false;
    const bf16_t* xb; bf16_t* pb16; float* st;
    struct Row {};
    __device__ __forceinline__ Row row_begin(int) const { return Row{}; }
    __device__ __forceinline__ f32x4 load(const Row&, int r, int c) const { return up4(*(const u32x2*)(xb + (size_t)r * DM + c)); }
    __device__ __forceinline__ void vec(const Row&, int r, int c, f32x4 v, f32x4 xv, float& s, float& q) const {
        const f32x4 pv = xv * ALPHA + v;
        *(u32x2*)(pb16 + (size_t)r * DM + c) = pk4(pv);
        s += (pv[0] + pv[1]) + (pv[2] + pv[3]);
        q += (pv[0] * pv[0] + pv[1] * pv[1]) + (pv[2] * pv[2] + pv[3] * pv[3]);
    }
    __device__ __forceinline__ void row_end(int r, float s, float q) const { atomicAdd(st + 2 * r, s); atomicAdd(st + 2 * r + 1, q); }
};
struct EpiGU {
    static constexpr bool GU = true, STATS = false, AFTER_DRAIN = false;
    const float* st; const float* cs; const float* bw; bf16_t* hid;
    struct Row { float mu, rstd; };
    __device__ __forceinline__ Row row_begin(int r) const { Row R; ln_stats(st, r, R.mu, R.rstd); return R; }
    __device__ __forceinline__ void vec2(const Row& R, int r, int ff, int cgi, f32x4 ga, f32x4 ua) const {
        const f32x4 csg = *(const f32x4*)(cs + cgi), csu = *(const f32x4*)(cs + cgi + 128);
        const f32x4 bwg = *(const f32x4*)(bw + cgi), bwu = *(const f32x4*)(bw + cgi + 128);
        vec2c(R, r, ff, ga, ua, csg, csu, bwg, bwu);
    }
    __device__ __forceinline__ void vec2c(const Row& R, int r, int ff, f32x4 ga, f32x4 ua, f32x4 csg, f32x4 csu, f32x4 bwg, f32x4 bwu) const {
        const f32x4 gt = (ga - csg * R.mu) * R.rstd + bwg;
        const f32x4 up = (ua - csu * R.mu) * R.rstd + bwu;
        f32x4 hv;
#pragma unroll
        for (int e = 0; e < 4; ++e) hv[e] = gt[e] * __builtin_amdgcn_rcpf(1.0f + __expf(-gt[e])) * up[e];
        *(u32x2*)(hid + (size_t)r * DFF + ff) = pk4(hv);
    }
};
struct EpiDown {
    static constexpr bool GU = false, STATS = true, AFTER_DRAIN = false;
    const bf16_t* pb16; const float* st1; const float* g1; const float* b1; float* st2; float* yo;
    struct Row { float mu, rstd; };
    __device__ __forceinline__ Row row_begin(int r) const { Row R; ln_stats(st1, r, R.mu, R.rstd); return R; }
    __device__ __forceinline__ f32x4 load(const Row&, int r, int c) const { return up4(*(const u32x2*)(pb16 + (size_t)r * DM + c)); }
    __device__ __forceinline__ void vec(const Row& R, int r, int c, f32x4 v, f32x4 pv, float& s, float& q) const {
        const f32x4 gv = *(const f32x4*)(g1 + c), bv = *(const f32x4*)(b1 + c);
        const f32x4 x1 = (pv - R.mu) * R.rstd * gv + bv;
        const f32x4 o = x1 * ALPHA + v;
        *(f32x4*)(yo + (size_t)r * DM + c) = o;
        s += (o[0] + o[1]) + (o[2] + o[3]);
        q += (o[0] * o[0] + o[1] * o[1]) + (o[2] * o[2] + o[3] * o[3]);
    }
    __device__ __forceinline__ void row_end(int r, float s, float q) const { atomicAdd(st2 + 2 * r, s); atomicAdd(st2 + 2 * r + 1, q); }
};

__device__ __forceinline__ void panel_meet(unsigned* cnt, unsigned want) {
    asm volatile("s_waitcnt vmcnt(0)" ::: "memory");
    __syncthreads();
    if (threadIdx.x == 0) {
        __builtin_amdgcn_fence(__ATOMIC_RELEASE, "agent");
        asm volatile("s_waitcnt vmcnt(0)" ::: "memory");
        __hip_atomic_fetch_add(cnt, 1u, __ATOMIC_RELAXED, __HIP_MEMORY_SCOPE_AGENT);
        unsigned sp = 0;
        while (__hip_atomic_load(cnt, __ATOMIC_RELAXED, __HIP_MEMORY_SCOPE_AGENT) < want) { __builtin_amdgcn_s_sleep(1); if (++sp > (1u << 24)) break; }
    }
    __syncthreads();
}
__device__ __forceinline__ void ln_stats_agent(float* st, int r, float& mu, float& rstd) {
    const float s = __hip_atomic_load(st + 2 * r, __ATOMIC_RELAXED, __HIP_MEMORY_SCOPE_AGENT), q = __hip_atomic_load(st + 2 * r + 1, __ATOMIC_RELAXED, __HIP_MEMORY_SCOPE_AGENT);
    mu = s * (1.0f / DM); const float var = q * (1.0f / DM) - mu * mu; rstd = rsqrtf(var + LN_EPS);
}
struct EpiDownF {
    static constexpr bool GU = false, STATS = true, AFTER_DRAIN = true;
    const bf16_t* pb16; const float* st1; const float* g1; const float* b1; float* st2; float* yo; const float* g2; const float* b2; unsigned* cnt;
    struct Row { float mu, rstd; };
    __device__ __forceinline__ Row row_begin(int r) const { Row R; ln_stats(st1, r, R.mu, R.rstd); return R; }
    __device__ __forceinline__ f32x4 load(const Row&, int r, int c) const { return up4(*(const u32x2*)(pb16 + (size_t)r * DM + c)); }
    __device__ __forceinline__ f32x4 pre2(const Row& R, int c, f32x4 v, f32x4 pv, float& s, float& q) const {
        const f32x4 gv = *(const f32x4*)(g1 + c), bv = *(const f32x4*)(b1 + c);
        const f32x4 x1 = (pv - R.mu) * R.rstd * gv + bv;
        const f32x4 o = x1 * ALPHA + v;
        s += (o[0] + o[1]) + (o[2] + o[3]);
        q += (o[0] * o[0] + o[1] * o[1]) + (o[2] * o[2] + o[3] * o[3]);
        return o;
    }
    __device__ __forceinline__ void vec(const Row& R, int r, int c, f32x4 v, f32x4 pv, float& s, float& q) const { *(f32x4*)(yo + (size_t)r * DM + c) = pre2(R, c, v, pv, s, q); }
    __device__ __forceinline__ void row_end(int r, float s, float q) const { atomicAdd(st2 + 2 * r, s); atomicAdd(st2 + 2 * r + 1, q); }
    __device__ __forceinline__ void fused(f32x4 (&acc)[2][2][4][2], const Unit& u, int wr, int wc, int fr, int fq) const {
        const int rbase = u.pm * 256 + wr * 64 + fr, cbase = u.pn * 256 + wc * 32 + 4 * fq;
        {
            Row Rn = row_begin(rbase);
            f32x4 inn[4];
#pragma unroll
            for (int j = 0; j < 4; ++j) inn[j] = load(Rn, rbase, cbase + (j >> 1) * 128 + (j & 1) * 16);
#pragma unroll
            for (int g = 0; g < 8; ++g) {
                const int ai = g >> 2, m = g & 3, r = rbase + ai * 128 + m * 16;
                const Row R = Rn;
                f32x4 in[4];
#pragma unroll
                for (int j = 0; j < 4; ++j) in[j] = inn[j];
                if (g < 7) {
                    const int r2 = rbase + ((g + 1) >> 2) * 128 + ((g + 1) & 3) * 16;
                    Rn = row_begin(r2);
#pragma unroll
                    for (int j = 0; j < 4; ++j) inn[j] = load(Rn, r2, cbase + (j >> 1) * 128 + (j & 1) * 16);
                }
                float s = 0.f, q = 0.f;
#pragma unroll
                for (int j = 0; j < 4; ++j) acc[ai][j >> 1][m][j & 1] = pre2(R, cbase + (j >> 1) * 128 + (j & 1) * 16, acc[ai][j >> 1][m][j & 1], in[j], s, q);
                s += __shfl_xor(s, 16); s += __shfl_xor(s, 32);
                q += __shfl_xor(q, 16); q += __shfl_xor(q, 32);
                if (fq == 0) row_end(r, s, q);
            }
        }
        panel_meet(cnt + 64 * u.pm, 4u);
        f32x4 gv[4], bv[4];
#pragma unroll
        for (int j = 0; j < 4; ++j) { const int c = cbase + (j >> 1) * 128 + (j & 1) * 16; gv[j] = *(const f32x4*)(g2 + c); bv[j] = *(const f32x4*)(b2 + c); }
        float mu8[8], rs8[8];
#pragma unroll
        for (int g = 0; g < 8; ++g) ln_stats_agent(st2, rbase + (g >> 2) * 128 + (g & 3) * 16, mu8[g], rs8[g]);
#pragma unroll
        for (int g = 0; g < 8; ++g) {
            const int ai = g >> 2, m = g & 3, r = rbase + ai * 128 + m * 16;
            const float mu = mu8[g], rstd = rs8[g];
#pragma unroll
            for (int j = 0; j < 4; ++j) __builtin_nontemporal_store((acc[ai][j >> 1][m][j & 1] - mu) * rstd * gv[j] + bv[j], (f32x4*)(yo + (size_t)r * DM + cbase + (j >> 1) * 128 + (j & 1) * 16));
        }
    }
    __device__ __forceinline__ void fused_mini(f32x4 (&acc)[2], int r, int rowblk, int c0, int fq) const {
        const Row R = row_begin(r);
        float s = 0.f, q = 0.f;
#pragma unroll
        for (int nb = 0; nb < 2; ++nb) acc[nb] = pre2(R, c0 + nb * 32, acc[nb], load(R, r, c0 + nb * 32), s, q);
        s += __shfl_xor(s, 16); s += __shfl_xor(s, 32);
        q += __shfl_xor(q, 16); q += __shfl_xor(q, 32);
        if (fq == 0) row_end(r, s, q);
        panel_meet(cnt + 64 * (64 + rowblk), 16u);
        float mu, rstd; ln_stats_agent(st2, r, mu, rstd);
#pragma unroll
        for (int nb = 0; nb < 2; ++nb) { const int c = c0 + nb * 32; *(f32x4*)(yo + (size_t)r * DM + c) = (acc[nb] - mu) * rstd * *(const f32x4*)(g2 + c) + *(const f32x4*)(b2 + c); }
    }
};

template <class Epi>
__device__ __forceinline__ void epi_main(const Epi& E, const f32x4 (&acc)[2][2][4][2], const Unit& u, int wr, int wc, int fr, int fq) {
    const int rbase = u.pm * 256 + wr * 64 + fr;
    if constexpr (Epi::GU) {
        f32x4 csg[2], csu[2], bwg[2], bwu[2];
#pragma unroll
        for (int n = 0; n < 2; ++n) {
            const int cgi = u.pn * 256 + wc * 32 + n * 16 + 4 * fq;
            csg[n] = *(const f32x4*)(E.cs + cgi); csu[n] = *(const f32x4*)(E.cs + cgi + 128);
            bwg[n] = *(const f32x4*)(E.bw + cgi); bwu[n] = *(const f32x4*)(E.bw + cgi + 128);
        }
        typename Epi::Row Rn = E.row_begin(rbase);
#pragma unroll
        for (int g = 0; g < 8; ++g) {
            const int ai = g >> 2, m = g & 3, r = rbase + ai * 128 + m * 16;
            const typename Epi::Row R = Rn;
            if (g < 7) Rn = E.row_begin(rbase + ((g + 1) >> 2) * 128 + ((g + 1) & 3) * 16);
#pragma unroll
            for (int n = 0; n < 2; ++n) E.vec2c(R, r, u.pn * 128 + wc * 32 + n * 16 + 4 * fq, acc[ai][0][m][n], acc[ai][1][m][n], csg[n], csu[n], bwg[n], bwu[n]);
        }
    } else {
        const int cbase = u.pn * 256 + wc * 32 + 4 * fq;
        typename Epi::Row Rn = E.row_begin(rbase);
        f32x4 inn[4];
#pragma unroll
        for (int j = 0; j < 4; ++j) inn[j] = E.load(Rn, rbase, cbase + (j >> 1) * 128 + (j & 1) * 16);
#pragma unroll
        for (int g = 0; g < 8; ++g) {
            const int ai = g >> 2, m = g & 3, r = rbase + ai * 128 + m * 16;
            const typename Epi::Row R = Rn;
            f32x4 in[4];
#pragma unroll
            for (int j = 0; j < 4; ++j) in[j] = inn[j];
            if (g < 7) {
                const int r2 = rbase + ((g + 1) >> 2) * 128 + ((g + 1) & 3) * 16;
                Rn = E.row_begin(r2);
#pragma unroll
                for (int j = 0; j < 4; ++j) inn[j] = E.load(Rn, r2, cbase + (j >> 1) * 128 + (j & 1) * 16);
            }
            float s = 0.f, q = 0.f;
#pragma unroll
            for (int j = 0; j < 4; ++j) E.vec(R, r, cbase + (j >> 1) * 128 + (j & 1) * 16, acc[ai][j >> 1][m][j & 1], in[j], s, q);
            if constexpr (Epi::STATS) {
                s += __shfl_xor(s, 16); s += __shfl_xor(s, 32);
                q += __shfl_xor(q, 16); q += __shfl_xor(q, 32);
                if (fq == 0) E.row_end(r, s, q);
            }
        }
    }
}

template <class Epi>
__device__ __forceinline__ void mini_gemm_tile(LAS unsigned char* lds, const bf16_t* __restrict__ A, const bf16_t* __restrict__ Bt, int K, int m0, int nt_idx, const Epi& E) {
    constexpr int LDT = 136;
    LAS bf16_t* As = (LAS bf16_t*)lds;
    LAS bf16_t* Bs = As + 2 * 64 * LDT;
    const int tid = threadIdx.x, lane = tid & 63, wave = tid >> 6, wr = wave >> 1, wc = wave & 1, fr = lane & 15, fq = lane >> 4;
    const int lrow = tid >> 3, lcol = (tid & 7) * 8;
    int brow;
    if constexpr (Epi::GU) brow = (nt_idx >> 2) * 256 + (lrow >> 5) * 128 + (nt_idx & 3) * 32 + (lrow & 31); else brow = nt_idx * 64 + lrow;
    const bf16_t* ap = A + (size_t)(m0 + lrow) * K + lcol;
    const bf16_t* bp = Bt + (size_t)brow * K + lcol;
    u32x4 ra[4], rb[4], rc[4], rd[4];
#define MG_LOAD(r, kt) do { r[0] = *(const u32x4*)(ap + (kt) * 128); r[1] = *(const u32x4*)(ap + (kt) * 128 + 64); r[2] = *(const u32x4*)(bp + (kt) * 128); r[3] = *(const u32x4*)(bp + (kt) * 128 + 64); } while (0)
#define MG_STORE(r, buf) do { *(LAS u32x4*)(As + ((buf) * 64 + lrow) * LDT + lcol) = r[0]; *(LAS u32x4*)(As + ((buf) * 64 + lrow) * LDT + lcol + 64) = r[1]; \
                              *(LAS u32x4*)(Bs + ((buf) * 64 + lrow) * LDT + lcol) = r[2]; *(LAS u32x4*)(Bs + ((buf) * 64 + lrow) * LDT + lcol + 64) = r[3]; } while (0)
#define MG_COMPUTE(buf) do { _Pragma("unroll") for (int ks = 0; ks < 4; ++ks) { \
        const bf16x8 af = *(const LAS bf16x8*)(As + ((buf) * 64 + wr * 16 + fr) * LDT + ks * 32 + fq * 8); \
        _Pragma("unroll") for (int nb = 0; nb < 2; ++nb) { const bf16x8 bfr = *(const LAS bf16x8*)(Bs + ((buf) * 64 + nb * 32 + wc * 16 + fr) * LDT + ks * 32 + fq * 8); \
            acc[nb] = __builtin_amdgcn_mfma_f32_16x16x32_bf16(bfr, af, acc[nb], 0, 0, 0); } } } while (0)
#define MG_STEP(r, kt_, buf) do { MG_STORE(r, buf); __syncthreads(); if ((kt_) + 4 < nkt) MG_LOAD(r, (kt_) + 4); MG_COMPUTE(buf); } while (0)
    f32x4 acc[2] = {(f32x4){0.f, 0.f, 0.f, 0.f}, (f32x4){0.f, 0.f, 0.f, 0.f}};
    const int nkt = K / 128;
    MG_LOAD(ra, 0); MG_LOAD(rb, 1); MG_LOAD(rc, 2); MG_LOAD(rd, 3);
    int kt = 0;
    for (; kt + 4 <= nkt; kt += 4) { MG_STEP(ra, kt, 0); MG_STEP(rb, kt + 1, 1); MG_STEP(rc, kt + 2, 0); MG_STEP(rd, kt + 3, 1); }
    if (kt < nkt) { MG_STEP(ra, kt, 0); MG_STEP(rb, kt + 1, 1); }
    __syncthreads();
#undef MG_STEP
#undef MG_LOAD
#undef MG_STORE
#undef MG_COMPUTE
    const int r = m0 + wr * 16 + fr;
    if constexpr (Epi::AFTER_DRAIN) { E.fused_mini(acc, r, (m0 - MP) >> 6, nt_idx * 64 + wc * 16 + 4 * fq, fq); return; }
    const typename Epi::Row R = E.row_begin(r);
    if constexpr (Epi::GU) {
        const int pn = nt_idx >> 2, ffo = (nt_idx & 3) * 32;
        E.vec2(R, r, pn * 128 + ffo + wc * 16 + 4 * fq, pn * 256 + ffo + wc * 16 + 4 * fq, acc[0], acc[1]);
    } else {
        float s = 0.f, q = 0.f;
#pragma unroll
        for (int nb = 0; nb < 2; ++nb) { const int c = nt_idx * 64 + nb * 32 + wc * 16 + 4 * fq; E.vec(R, r, c, acc[nb], E.load(R, r, c), s, q); }
        if constexpr (Epi::STATS) {
            s += __shfl_xor(s, 16); s += __shfl_xor(s, 32);
            q += __shfl_xor(q, 16); q += __shfl_xor(q, 32);
            if (fq == 0) E.row_end(r, s, q);
        }
    }
}
template <class Epi>
__device__ __forceinline__ void mini_gemm_phase(LAS unsigned char* lds, const bf16_t* A, const bf16_t* Bt, int K, int ntiles_n, int wg0, int nwg, const Epi& E) {
    const int me = (int)blockIdx.x - wg0;
    if (me < 0 || me >= nwg) return;
    for (int it = me; it < 4 * ntiles_n; it += nwg) mini_gemm_tile(lds, A, Bt, K, MP + (it & 3) * 64, it >> 2, E);
}

__device__ __forceinline__ void transpose_item(const float* __restrict__ src, int K, int N, int n0, bf16_t* __restrict__ dst, int ldd,
                                               const float* __restrict__ gs, const float* __restrict__ bv, float* cs_out, float* bw_out, LAS float* tile) {
    const int tid = threadIdx.x, ln = tid & 63, lr = tid >> 6;
    const int nt = K / 64;
    float cur[8], nxt[8];
#pragma unroll
    for (int i = 0; i < 8; ++i) cur[i] = src[(size_t)(lr + 8 * i) * N + n0 + ln];
    float csp = 0.f, bwp = 0.f;
    for (int t = 0; t < nt; ++t) {
        if (t + 1 < nt) {
#pragma unroll
            for (int i = 0; i < 8; ++i) nxt[i] = src[(size_t)((t + 1) * 64 + lr + 8 * i) * N + n0 + ln];
        }
        LAS float* tl = tile + (t & 1) * (64 * 65);
#pragma unroll
        for (int i = 0; i < 8; ++i) {
            const int k = t * 64 + lr + 8 * i;
            const float g = gs ? gs[k] : 1.0f; const float b = bv ? bv[k] : 0.0f;
            const float w = bf2f(f2bf(cur[i] * g));
            csp += w; bwp += b * cur[i];
            tl[(lr + 8 * i) * 65 + ln] = w;
        }
        __syncthreads();
#pragma unroll
        for (int i = 0; i < 8; ++i) {
            const int n = lr + 8 * i;
            dst[(size_t)n * ldd + t * 64 + ln] = f2bf(tl[ln * 65 + n]);
        }
#pragma unroll
        for (int i = 0; i < 8; ++i) cur[i] = nxt[i];
    }
    __syncthreads();
    if (cs_out) {
        LAS float* red = tile;
        red[lr * 64 + ln] = csp; red[512 + lr * 64 + ln] = bwp;
        __syncthreads();
        if (tid < 64) {
            float a = 0.f, b = 0.f;
#pragma unroll
            for (int i = 0; i < 8; ++i) { a += red[i * 64 + tid]; b += red[512 + i * 64 + tid]; }
            cs_out[tid] = a; bw_out[tid] = b;
        }
        __syncthreads();
    }
}

__device__ void phase0(const Params& p, LAS unsigned char* lds) {
    const int tid = threadIdx.x, nb = gridDim.x, bid = blockIdx.x;
    LAS float* tile = (LAS float*)lds;
    bf16_t* WinT = (bf16_t*)(p.ws + WS_WIN); bf16_t* WoutT = (bf16_t*)(p.ws + WS_WOUT); bf16_t* WguT = (bf16_t*)(p.ws + WS_WGU); bf16_t* WdT = (bf16_t*)(p.ws + WS_WD);
    bf16_t* pwT = (bf16_t*)(p.ws + WS_PWT); float* cs = (float*)(p.ws + WS_CS); float* bw = (float*)(p.ws + WS_BW);
    for (int item = bid; item < 160; item += nb) {
        if (item < 32) { const int n0 = item * 64; transpose_item(p.w_in, DM, NIN, n0, WinT + (size_t)n0 * DM, DM, nullptr, nullptr, nullptr, nullptr, tile); }
        else if (item < 48) { const int n0 = (item - 32) * 64; transpose_item(p.w_out, DM, DM, n0, WoutT + (size_t)n0 * DM, DM, nullptr, nullptr, nullptr, nullptr, tile); }
        else if (item < 136) {
            const int isu = item >= 92; const int n0 = (item - (isu ? 92 : 48)) * 64;
            const int drow = (n0 >> 7) * 256 + isu * 128 + (n0 & 127);
            transpose_item(isu ? p.wu : p.wg, DM, DFF, n0, WguT + (size_t)drow * DM, DM, p.ln1g, p.ln1b, cs + drow, bw + drow, tile);
        }
        else if (item < 152) { const int n0 = (item - 136) * 64; transpose_item(p.wd, DFF, DM, n0, WdT + (size_t)n0 * DFF, DFF, nullptr, nullptr, nullptr, nullptr, tile); }
        else { const int j = item - 152, g = j >> 1, n0 = (j & 1) * 64; transpose_item(p.pool_w + (size_t)g * 16384, 128, 128, n0, pwT + (size_t)g * 16384 + (size_t)n0 * 128, 128, nullptr, nullptr, nullptr, nullptr, tile); }
    }
    {
        bf16_t* xb = (bf16_t*)(p.ws + WS_A);
        const size_t n8 = (size_t)MT * DM / 8, np8 = (size_t)MP * DM / 8;
        for (size_t i = (size_t)bid * 512 + tid; i < n8; i += (size_t)nb * 512) {
            const f32x4* s = (i < np8) ? (const f32x4*)p.xp + 2 * i : (const f32x4*)p.xs + 2 * (i - np8);
            const f32x4 a = __builtin_nontemporal_load(s), b = __builtin_nontemporal_load(s + 1);
            u32x4 o; o.x = pk_bf16(a[0], a[1]); o.y = pk_bf16(a[2], a[3]); o.z = pk_bf16(b[0], b[1]); o.w = pk_bf16(b[2], b[3]);
            ((u32x4*)xb)[i] = o;
        }
    }
    {
        float* st = (float*)(p.ws + WS_ST1);
        for (int i = bid * 512 + tid; i < MT * 4; i += nb * 512) st[i] = 0.f;
    }
}

__device__ __forceinline__ float softplus2_f(float z2) { return fmaxf(z2, 0.f) + __builtin_amdgcn_logf(1.0f + __builtin_amdgcn_exp2f(-fabsf(z2))); }

__device__ __forceinline__ void attn_tile_t(const bf16x8 (&Kf)[2][2], const bf16x8 (&Qf)[2][2], LAS unsigned short* vt, f32x4 (&O)[2][4], float (&R)[2], bool DIAG, int c16, int g) {
    bf16x8 Vf[4];
#pragma unroll
    for (int db = 0; db < 4; ++db) {
        const u32x2 lo = *(const LAS u32x2*)(vt + (db * 16 + c16) * 36 + g * 4);
        const u32x2 hi = *(const LAS u32x2*)(vt + (db * 16 + c16) * 36 + 16 + g * 4);
        u32x4 o; o.x = lo.x; o.y = lo.y; o.z = hi.x; o.w = hi.y;
        Vf[db] = __builtin_bit_cast(bf16x8, o);
    }
#pragma unroll
    for (int qb = 0; qb < 2; ++qb) {
        f32x4 z[2];
#pragma unroll
        for (int kb = 0; kb < 2; ++kb) {
            z[kb] = __builtin_amdgcn_mfma_f32_16x16x32_bf16(Kf[kb][0], Qf[qb][0], (f32x4){0.f, 0.f, 0.f, 0.f}, 0, 0, 0);
            z[kb] = __builtin_amdgcn_mfma_f32_16x16x32_bf16(Kf[kb][1], Qf[qb][1], z[kb], 0, 0, 0);
        }
        float sp[2][4], lb[2][4]; bool ok[2][4];
        const int qrel = qb * 16 + c16;
#pragma unroll
        for (int kb = 0; kb < 2; ++kb)
#pragma unroll
            for (int j = 0; j < 4; ++j) {
                const int krel = kb * 16 + g * 4 + j;
                ok[kb][j] = (!DIAG) || (krel < qrel);
                const float zz = z[kb][j]; const float sf = softplus2_f(zz);
                sp[kb][j] = ok[kb][j] ? sf : 0.f; lb[kb][j] = zz - sf;
            }
        float ex[2][4], tot[2], hg[2], bt[2];
#pragma unroll
        for (int kb = 0; kb < 2; ++kb) {
            ex[kb][3] = 0.f; ex[kb][2] = sp[kb][3]; ex[kb][1] = ex[kb][2] + sp[kb][2]; ex[kb][0] = ex[kb][1] + sp[kb][1];
            tot[kb] = ex[kb][0] + sp[kb][0];
            const float a1 = __shfl_xor(tot[kb], 16), a2 = __shfl_xor(tot[kb], 32), a3 = __shfl_xor(tot[kb], 48);
            hg[kb] = (g == 0) ? (a1 + a2 + a3) : (g == 1) ? (a2 + a3) : (g == 2) ? a1 : 0.f;
            bt[kb] = (tot[kb] + a1) + (a2 + a3);
        }
        float pr[2][4];
#pragma unroll
        for (int j = 0; j < 4; ++j) {
            const float af1 = R[qb] + hg[1] + ex[1][j];
            const float af0 = R[qb] + bt[1] + hg[0] + ex[0][j];
            pr[1][j] = ok[1][j] ? __builtin_amdgcn_exp2f(lb[1][j] - af1) : 0.f;
            pr[0][j] = ok[0][j] ? __builtin_amdgcn_exp2f(lb[0][j] - af0) : 0.f;
        }
        R[qb] += bt[0] + bt[1];
        u32x4 po; po.x = pk_bf16(pr[0][0], pr[0][1]); po.y = pk_bf16(pr[0][2], pr[0][3]); po.z = pk_bf16(pr[1][0], pr[1][1]); po.w = pk_bf16(pr[1][2], pr[1][3]);
        const bf16x8 Pf = __builtin_bit_cast(bf16x8, po);
#pragma unroll
        for (int db = 0; db < 4; ++db) O[qb][db] = __builtin_amdgcn_mfma_f32_16x16x32_bf16(Vf[db], Pf, O[qb][db], 0, 0, 0);
    }
}
__device__ __forceinline__ void attn_tile(const bf16x8 (&Kf)[2][2], const bf16x8 (&Qf)[2][2], LAS unsigned short* vt, f32x4 (&O)[2][4], float (&R)[2], bool diag, int c16, int g) {
    attn_tile_t(Kf, Qf, vt, O, R, diag, c16, g);
}
#define WAVE_LDS_SYNC() do { asm volatile("" ::: "memory"); __builtin_amdgcn_wave_barrier(); asm volatile("" ::: "memory"); } while (0)

__device__ __forceinline__ void attn_item(const Params& p, int item, const bf16_t* __restrict__ qkvb, bf16_t* __restrict__ concat, LAS unsigned short* vt, int lane) {
    const bool prompt = item < 4096;
    int b, h, qt;
    if (prompt) { qt = item & 127; h = (item >> 7) & 7; b = item >> 10; } else { const int s = item - 4096; h = s & 7; b = s >> 3; qt = 0; }
    const size_t rowq = (prompt ? (size_t)b * SEQ : (size_t)MP + b * DSEQ) + qt * 32;
    const int qpos0 = (prompt ? 0 : PAST) + qt * 32;
    const int c16 = lane & 15, g = lane >> 4;
    bf16x8 Qf[2][2];
#pragma unroll
    for (int qb = 0; qb < 2; ++qb)
#pragma unroll
        for (int dh = 0; dh < 2; ++dh) Qf[qb][dh] = *(const bf16x8*)(qkvb + (rowq + qb * 16 + c16) * 1536 + h * 64 + dh * 32 + g * 8);
    f32x4 O[2][4];
#pragma unroll
    for (int qb = 0; qb < 2; ++qb)
#pragma unroll
        for (int db = 0; db < 4; ++db) O[qb][db] = (f32x4){0.f, 0.f, 0.f, 0.f};
    float R[2] = {0.f, 0.f};
    const int key = lane >> 1, dhalf = (lane & 1) * 32;
#ifndef ATTN_PREFETCH
#define ATTN_PREFETCH 0
#endif
    if (ATTN_PREFETCH && prompt) {
        const bf16_t* kbase = qkvb + ((size_t)b * SEQ + c16) * 1536 + 512 + h * 64 + g * 8;
        const bf16_t* vbase = qkvb + ((size_t)b * SEQ + key) * 1536 + 1024 + h * 64 + dhalf;
        bf16x8 Kr[2][2], Vr[4];
#define AT_LOAD(kp0) do { _Pragma("unroll") for (int kb = 0; kb < 2; ++kb) _Pragma("unroll") for (int dh = 0; dh < 2; ++dh) Kr[kb][dh] = *(const bf16x8*)(kbase + (size_t)((kp0) + kb * 16) * 1536 + dh * 32); \
                           _Pragma("unroll") for (int i = 0; i < 4; ++i) Vr[i] = *(const bf16x8*)(vbase + (size_t)(kp0) * 1536 + i * 8); } while (0)
        AT_LOAD(qpos0);
        for (int kt = qpos0 >> 5; kt >= 0; --kt) {
            bf16x8 Kf[2][2];
#pragma unroll
            for (int kb = 0; kb < 2; ++kb)
#pragma unroll
                for (int dh = 0; dh < 2; ++dh) Kf[kb][dh] = Kr[kb][dh];
#pragma unroll
            for (int i = 0; i < 4; ++i)
#pragma unroll
                for (int e = 0; e < 8; ++e) vt[(dhalf + i * 8 + e) * 36 + key] = (unsigned short)Vr[i][e];
            if (kt > 0) AT_LOAD((kt - 1) << 5);
            WAVE_LDS_SYNC();
            attn_tile(Kf, Qf, vt, O, R, (kt << 5) == qpos0, c16, g);
            WAVE_LDS_SYNC();
            if (__all(fminf(R[0], R[1]) > R_EXIT)) break;
        }
#undef AT_LOAD
    } else {
        for (int kt = qpos0 >> 5; kt >= 0; --kt) {
            const int kp0 = kt << 5;
            bf16x8 Kf[2][2];
            if (prompt || kp0 >= PAST) {
                const size_t krow = prompt ? (size_t)b * SEQ + kp0 : (size_t)MP + b * DSEQ + (kp0 - PAST);
#pragma unroll
                for (int kb = 0; kb < 2; ++kb)
#pragma unroll
                    for (int dh = 0; dh < 2; ++dh) Kf[kb][dh] = *(const bf16x8*)(qkvb + (krow + kb * 16 + c16) * 1536 + 512 + h * 64 + dh * 32 + g * 8);
                const bf16_t* vp = qkvb + (krow + key) * 1536 + 1024 + h * 64 + dhalf;
#pragma unroll
                for (int i = 0; i < 4; ++i) {
                    const bf16x8 v = *(const bf16x8*)(vp + i * 8);
#pragma unroll
                    for (int e = 0; e < 8; ++e) vt[(dhalf + i * 8 + e) * 36 + key] = (unsigned short)v[e];
                }
            } else {
                const float* kp = p.ck + ((size_t)(b * PAST + kp0) * 8 + h) * 64;
#pragma unroll
                for (int kb = 0; kb < 2; ++kb)
#pragma unroll
                    for (int dh = 0; dh < 2; ++dh) {
                        const float* sp_ = kp + (size_t)(kb * 16 + c16) * 512 + dh * 32 + g * 8;
                        const f32x4 a = *(const f32x4*)sp_, bb = *(const f32x4*)(sp_ + 4);
                        u32x4 o; o.x = pk_bf16(a[0], a[1]); o.y = pk_bf16(a[2], a[3]); o.z = pk_bf16(bb[0], bb[1]); o.w = pk_bf16(bb[2], bb[3]);
                        Kf[kb][dh] = __builtin_bit_cast(bf16x8, o);
                    }
                const float* vp = p.cv + ((size_t)(b * PAST + kp0 + key) * 8 + h) * 64 + dhalf;
#pragma unroll
                for (int i = 0; i < 8; ++i) {
                    const f32x4 v = *(const f32x4*)(vp + i * 4);
#pragma unroll
                    for (int e = 0; e < 4; ++e) vt[(dhalf + i * 4 + e) * 36 + key] = f2bf(v[e]);
                }
            }
            WAVE_LDS_SYNC();
            attn_tile(Kf, Qf, vt, O, R, kp0 == qpos0, c16, g);
            WAVE_LDS_SYNC();
            if (__all(fminf(R[0], R[1]) > R_EXIT)) break;
        }
    }
#pragma unroll
    for (int qb = 0; qb < 2; ++qb)
#pragma unroll
        for (int db = 0; db < 4; ++db)
            *(u32x2*)(concat + (rowq + qb * 16 + c16) * DM + h * 64 + db * 16 + g * 4) = pk4(O[qb][db]);
}

template <int G>
__device__ __forceinline__ void pool_item_g(const Params& p, int tokblk, const bf16_t* __restrict__ ubuf, const bf16_t* __restrict__ pwT, bf16_t* __restrict__ concat, LAS bf16_t* dt, int lane) {
    constexpr int W = 2 << G;
    const int r0 = tokblk * 16;
    int t0, start; size_t rb; const float* hist;
    if (r0 < MP) { t0 = r0 & (SEQ - 1); rb = (size_t)(r0 - t0); start = 0; hist = nullptr; }
    else { const int rr = r0 - MP; const int b = rr >> 5; t0 = rr & 31; rb = (size_t)MP + b * DSEQ; start = PAST; hist = p.sp + (size_t)b * 15 * 512; }
    const int c16 = lane & 15, gq = lane >> 4;
    const bf16_t* wbase = pwT + (size_t)G * 16384 + (size_t)c16 * 128 + gq * 8;
    float v[2][15 + W];
#pragma unroll
    for (int half = 0; half < 2; ++half) {
        const int ch = G * 128 + half * 64 + lane;
#pragma unroll
        for (int i = 0; i < 15 + W; ++i) {
            const int t = t0 - (W - 1) + i;
            const int tc = (t >= 0) ? t : 0;
            const float xu = bf2f(ubuf[(rb + tc) * 512 + ch]);
            const float xh = (t < 0 && hist) ? hist[(size_t)(15 + t) * 512 + ch] : 0.f;
            v[half][i] = (t >= 0) ? xu : xh;
        }
    }
#pragma unroll
    for (int half = 0; half < 2; ++half) {
        float s = 0.f;
#pragma unroll
        for (int i = 0; i < W - 1; ++i) s += v[half][i];
#pragma unroll
        for (int i = 0; i < 16; ++i) {
            const float cur = v[half][W - 1 + i];
            s += cur;
            const int cnt = min(W, start + t0 + i + 1);
            const float d = s / (float)cnt - cur;
            dt[i * 136 + half * 64 + lane] = f2bf(d);
            s -= v[half][i];
        }
    }
    WAVE_LDS_SYNC();
    f32x4 acc[8];
    bf16x8 bfrag[4];
#pragma unroll
    for (int ks = 0; ks < 4; ++ks) bfrag[ks] = *(const LAS bf16x8*)(dt + c16 * 136 + ks * 32 + gq * 8);
    const bf16_t* wp = wbase;
    asm volatile("" : "+v"(wp));
    bf16x8 wa[8][4];
#pragma unroll
    for (int nb = 0; nb < 8; ++nb)
#pragma unroll
        for (int ks = 0; ks < 4; ++ks) wa[nb][ks] = *(const bf16x8*)(wp + (size_t)nb * 16 * 128 + ks * 32);
    asm volatile("" ::: "memory");
#pragma unroll
    for (int nb = 0; nb < 8; ++nb) {
        acc[nb] = (f32x4){0.f, 0.f, 0.f, 0.f};
#pragma unroll
        for (int ks = 0; ks < 4; ++ks) acc[nb] = __builtin_amdgcn_mfma_f32_16x16x32_bf16(wa[nb][ks], bfrag[ks], acc[nb], 0, 0, 0);
    }
    const int row = r0 + c16;
#pragma unroll
    for (int nb = 0; nb < 8; ++nb) {
        const int dout = G * 128 + nb * 16 + gq * 4;
        const f32x4 sc = *(const f32x4*)(p.pool_scale + dout);
        *(u32x2*)(concat + (size_t)row * DM + 512 + dout) = pk4(acc[nb] * sc);
    }
    WAVE_LDS_SYNC();
}

constexpr int P2_ITEMS = 8320, P2_PER_Q = P2_ITEMS / 8;
__device__ __forceinline__ void phase2(const Params& p, LAS unsigned char* lds, const bf16_t* qkvb, const bf16_t* ubuf, bf16_t* concat) {
    const int tid = threadIdx.x, wave = tid >> 6, lane = tid & 63;
    LAS unsigned short* wl = (LAS unsigned short*)(lds + wave * 4608);
    unsigned* ctr = (unsigned*)(p.ws + WS_BAR + 14336);
    const bf16_t* pwT = (const bf16_t*)(p.ws + WS_PWT);
#ifndef P2_STATIC
#define P2_STATIC 0
#endif
#if P2_STATIC
    for (int item = (int)blockIdx.x * 8 + wave; item < P2_ITEMS; item += (int)gridDim.x * 8) {
        {
#else
    const int q0 = blockIdx.x & 7;
    for (int qq = 0; qq < 8; ++qq) {
        const int qi = (q0 + qq) & 7;
        for (;;) {
            unsigned i = 0;
            if (lane == 0) i = __hip_atomic_fetch_add(ctr + qi * 64, 1u, __ATOMIC_RELAXED, __HIP_MEMORY_SCOPE_AGENT);
            i = (unsigned)__builtin_amdgcn_readfirstlane((int)i);
            if (i >= (unsigned)P2_PER_Q) break;
            const int seq = (int)i * 8 + qi;
            const int item = (seq & 1) ? 4160 + (seq >> 1) : (seq >> 1);
#endif
            if (item < 4160) attn_item(p, item, qkvb, concat, wl, lane);
            else {
                const int j = item - 4160, tokblk = j >> 2, g = j & 3;
                LAS bf16_t* dt = (LAS bf16_t*)wl;
                if (g == 0) pool_item_g<0>(p, tokblk, ubuf, pwT, concat, dt, lane);
                else if (g == 1) pool_item_g<1>(p, tokblk, ubuf, pwT, concat, dt, lane);
                else if (g == 2) pool_item_g<2>(p, tokblk, ubuf, pwT, concat, dt, lane);
                else pool_item_g<3>(p, tokblk, ubuf, pwT, concat, dt, lane);
            }
        }
    }
    (void)ctr;
}

__global__ void __launch_bounds__(512, 2) fwd_megakernel(Params p) {
    __shared__ __attribute__((aligned(16))) unsigned char smem[pg8::STAGE_BYTES];
    LAS unsigned char* lds = (LAS unsigned char*)smem;
    cg::grid_group grid = cg::this_grid();
    __shared__ uint4 xb_words;
    if (threadIdx.x == 0) xb_words = make_uint4(0u, 0u, 0u, 0u);
    __syncthreads();
    const XcdBarrier gbar = xcd_barrier_post((unsigned*)(p.ws + WS_BAR), (volatile LAS unsigned*)&xb_words);
    const int tid = threadIdx.x, bid = blockIdx.x, nb = gridDim.x;
    bf16_t* xb = (bf16_t*)(p.ws + WS_A); bf16_t* hid = (bf16_t*)(p.ws + WS_A);
    bf16_t* qkvb = (bf16_t*)(p.ws + WS_B); bf16_t* pb16 = (bf16_t*)(p.ws + WS_B); bf16_t* ubuf = (bf16_t*)(p.ws + WS_UB);
    bf16_t* concat = (bf16_t*)(p.ws + WS_C);
    float* st1 = (float*)(p.ws + WS_ST1); float* st2 = (float*)(p.ws + WS_ST2);
#ifndef PHMASK
#define PHMASK 127
#endif
#ifndef REPMASK
#define REPMASK 0
#endif
#ifndef REPBAR
#define REPBAR 0
#endif
#define PH_RUN(k, lam) if ((PHMASK & (1 << (k))) && p.ph_lo <= (k) && (k) < p.ph_hi) { if ((k) > p.ph_lo) { if (p.ph_lo < 0) grid.sync(); else xcd_barrier(gbar); } \
        if ((REPMASK >> (k)) & 1) { lam(true); if (REPBAR) xcd_barrier(gbar); else __syncthreads(); } lam(false); }
    float* const dummy_st = (float*)(p.ws + WS_END);
    float* const scratch_y = (float*)(p.ws + WS_B + (size_t)MT * DM * 2);
    auto ph0 = [&](bool) { phase0(p, lds); };
    auto ph1 = [&](bool) {
        pg8::StaticOrder S; S.init(MP, NIN, nb, bid);
        EpiIn E{qkvb, ubuf, p.out};
        pg8::gemm_phase(lds, pg8::Gemm{xb, (const bf16_t*)(p.ws + WS_WIN), MP, NIN, DM}, S, E);
        mini_gemm_phase(lds, xb, (const bf16_t*)(p.ws + WS_WIN), DM, NIN / 64, 0, nb < 128 ? nb : 128, E);
    };
    auto ph2 = [&](bool) { phase2(p, lds, qkvb, ubuf, concat); };
    auto ph3 = [&](bool probe) {
        pg8::StaticOrder S; S.init(MP, DM, nb, bid);
        EpiOut E{xb, pb16, probe ? dummy_st : st1};
        pg8::gemm_phase(lds, pg8::Gemm{concat, (const bf16_t*)(p.ws + WS_WOUT), MP, DM, DM}, S, E);
        mini_gemm_phase(lds, concat, (const bf16_t*)(p.ws + WS_WOUT), DM, DM / 64, 0, nb < 64 ? nb : 64, E);
    };
    auto ph4 = [&](bool) {
        pg8::StaticOrder S; S.init(MP, NGU, nb, bid);
        EpiGU E{st1, (const float*)(p.ws + WS_CS), (const float*)(p.ws + WS_BW), hid};
        pg8::gemm_phase(lds, pg8::Gemm{pb16, (const bf16_t*)(p.ws + WS_WGU), MP, NGU, DM}, S, E);
        mini_gemm_phase(lds, pb16, (const bf16_t*)(p.ws + WS_WGU), DM, DFF / 32, nb == 256 ? 128 : 0, nb == 256 ? 128 : nb, E);
    };
    const bool fuse_ln2 = (nb == MP / 256 * (DM / 256)) && !((REPMASK >> 5) & 1);
    auto ph5f = [&](bool) {
        pg8::StaticOrder S; S.init(MP, DM, nb, bid);
        EpiDownF E{pb16, st1, p.ln1g, p.ln1b, st2, p.out + OFF_YP, p.ln2g, p.ln2b, (unsigned*)(p.ws + WS_BAR + 16384)};
        pg8::gemm_phase(lds, pg8::Gemm{hid, (const bf16_t*)(p.ws + WS_WD), MP, DM, DFF}, S, E);
        mini_gemm_phase(lds, hid, (const bf16_t*)(p.ws + WS_WD), DFF, DM / 64, 0, 64, E);
    };
    auto ph5 = [&](bool probe) {
        if (fuse_ln2) { ph5f(probe); return; }
        pg8::StaticOrder S; S.init(MP, DM, nb, bid);
        EpiDown E{pb16, st1, p.ln1g, p.ln1b, probe ? dummy_st : st2, probe ? scratch_y : p.out + OFF_YP};
        pg8::gemm_phase(lds, pg8::Gemm{hid, (const bf16_t*)(p.ws + WS_WD), MP, DM, DFF}, S, E);
        mini_gemm_phase(lds, hid, (const bf16_t*)(p.ws + WS_WD), DFF, DM / 64, 0, nb < 64 ? nb : 64, E);
    };
    auto ph6 = [&](bool probe) {
        f32x4* y4 = (f32x4*)(p.out + OFF_YP);
        f32x4* yo4 = probe ? (f32x4*)scratch_y : y4;
        const size_t n4 = (size_t)MT * DM / 4;
        for (size_t i = (size_t)bid * 512 + tid; i < n4; i += (size_t)nb * 512) {
            const int r = (int)(i >> 8), c4 = (int)(i & 255);
            const float s = st2[2 * r], q = st2[2 * r + 1];
            const float mu = s * (1.0f / DM); const float var = q * (1.0f / DM) - mu * mu; const float rstd = rsqrtf(var + LN_EPS);
            const f32x4 v = y4[i], gv = ((const f32x4*)p.ln2g)[c4], bv = ((const f32x4*)p.ln2b)[c4];
            yo4[i] = (v - mu) * rstd * gv + bv;
        }
    };
    PH_RUN(0, ph0) PH_RUN(1, ph1) PH_RUN(2, ph2) PH_RUN(3, ph3) PH_RUN(4, ph4) PH_RUN(5, ph5) if (!fuse_ln2) { PH_RUN(6, ph6) }
}

extern "C" void kernel_launch(void* const* d_in, const int* in_sizes, int n_in, void* d_out, int out_size, void* d_ws, size_t ws_size, hipStream_t stream) {
    static int grid_blocks = 0;
    if (!grid_blocks) {
        int dev = 0, cus = 0, per_cu = 0;
        hipGetDevice(&dev);
        hipDeviceGetAttribute(&cus, hipDeviceAttributeMultiprocessorCount, dev);
        hipOccupancyMaxActiveBlocksPerMultiprocessor(&per_cu, fwd_megakernel, 512, 0);
        if (per_cu < 1) { fprintf(stderr, "occupancy query says %d blocks/CU\n", per_cu); per_cu = 1; }
        if (per_cu > 1) per_cu = 1;
        grid_blocks = cus * per_cu;
        if (ws_size < WS_END) fprintf(stderr, "workspace too small: %zu < %zu\n", ws_size, (size_t)WS_END);
    }
    Params p{};
    p.xp = (const float*)d_in[0]; p.xs = (const float*)d_in[1]; p.ck = (const float*)d_in[2]; p.cv = (const float*)d_in[3]; p.sp = (const float*)d_in[4];
    p.w_in = (const float*)d_in[5]; p.pool_w = (const float*)d_in[6]; p.pool_scale = (const float*)d_in[7]; p.w_out = (const float*)d_in[8];
    p.ln1g = (const float*)d_in[9]; p.ln1b = (const float*)d_in[10]; p.wg = (const float*)d_in[11]; p.wu = (const float*)d_in[12]; p.wd = (const float*)d_in[13];
    p.ln2g = (const float*)d_in[14]; p.ln2b = (const float*)d_in[15];
    p.out = (float*)d_out; p.ws = (unsigned char*)d_ws;
    (void)hipMemsetAsync((unsigned char*)d_ws + WS_BAR, 0, WS_BAR_BYTES, stream);
#if MULTI_LAUNCH
    for (int ph = 0; ph < 7; ++ph) { p.ph_lo = ph; p.ph_hi = ph + 1; hipLaunchKernelGGL(fwd_megakernel, dim3(grid_blocks), dim3(512), 0, stream, p); }
#else
    p.ph_lo = 0; p.ph_hi = 7;
    void* args[] = {&p};
    hipError_t e = hipLaunchCooperativeKernel((void*)fwd_megakernel, dim3(grid_blocks), dim3(512), args, 0, stream);
    if (e != hipSuccess) fprintf(stderr, "cooperative launch failed: %s (grid %d)\n", hipGetErrorString(e), grid_blocks);
#endif
}
```

```cpp
#include <hip/hip_runtime.h>
#include <hip/hip_cooperative_groups.h>
#include <cstdio>
namespace cg = cooperative_groups;

#ifndef MULTI_LAUNCH
#define MULTI_LAUNCH 0
#endif

#define LAS __attribute__((address_space(3)))
typedef unsigned short bf16_t;
typedef short bf16x8 __attribute__((ext_vector_type(8)));
typedef float f32x4 __attribute__((ext_vector_type(4)));
typedef unsigned u32x2 __attribute__((ext_vector_type(2)));
typedef unsigned u32x4 __attribute__((ext_vector_type(4)));

constexpr int MP = 16384, MS = 256, MT = MP + MS;
constexpr int DM = 1024, NIN = 2048, DFF = 2816, NGU = 2 * DFF;
constexpr int SEQ = 4096, DSEQ = 32, PAST = 2048;
constexpr float ALPHA = 1.189207115002721f;
constexpr float LN_EPS = 1e-5f;
constexpr float R_EXIT = 130.0f;

constexpr size_t OFF_YP = 0, OFF_YS = 16777216, OFF_KP = 17039360, OFF_VP = 25427968, OFF_PP = 33816576,
                 OFF_KS = 33847296, OFF_VS = 33978368, OFF_PS = 34109440;

constexpr size_t WS_WIN = 0;
constexpr size_t WS_WOUT = WS_WIN + (size_t)NIN * DM * 2;
constexpr size_t WS_WGU = WS_WOUT + (size_t)DM * DM * 2;
constexpr size_t WS_WD = WS_WGU + (size_t)NGU * DM * 2;
constexpr size_t WS_PWT = WS_WD + (size_t)DM * DFF * 2;
constexpr size_t WS_CS = WS_PWT + 4 * 128 * 128 * 2;
constexpr size_t WS_BW = WS_CS + (size_t)NGU * 4;
constexpr size_t WS_ST1 = WS_BW + (size_t)NGU * 4;
constexpr size_t WS_ST2 = WS_ST1 + (size_t)MT * 2 * 4;
constexpr size_t WS_BAR = WS_ST2 + (size_t)MT * 2 * 4;
constexpr size_t WS_BAR_BYTES = 36864;
constexpr size_t WS_A = 24117248;
constexpr size_t WS_B = WS_A + (size_t)MT * DFF * 2;
constexpr size_t WS_UB = WS_B + (size_t)MT * 1536 * 2;
constexpr size_t WS_C = WS_UB + (size_t)MT * 512 * 4;
constexpr size_t WS_END = WS_C + (size_t)MT * DM * 2;
static_assert(WS_BAR + WS_BAR_BYTES <= WS_A, "ws map");
static_assert(WS_END <= 268435456ull, "ws map");

struct Params {
    const float *xp, *xs, *ck, *cv, *sp, *w_in, *pool_w, *pool_scale, *w_out, *ln1g, *ln1b, *wg, *wu, *wd, *ln2g, *ln2b;
    float* out; unsigned char* ws; int ph_lo, ph_hi;
};

__device__ __forceinline__ unsigned pk_bf16(float lo, float hi) { unsigned r; asm("v_cvt_pk_bf16_f32 %0, %1, %2" : "=v"(r) : "v"(lo), "v"(hi)); return r; }
__device__ __forceinline__ bf16_t f2bf(float f) { unsigned u = __float_as_uint(f); u += 0x7FFFu + ((u >> 16) & 1u); return (bf16_t)(u >> 16); }
__device__ __forceinline__ float bf2f(bf16_t b) { return __uint_as_float(((unsigned)b) << 16); }
__device__ __forceinline__ f32x4 up4(u32x2 w) { f32x4 v; v[0] = __uint_as_float(w.x << 16); v[1] = __uint_as_float(w.x & 0xffff0000u); v[2] = __uint_as_float(w.y << 16); v[3] = __uint_as_float(w.y & 0xffff0000u); return v; }
__device__ __forceinline__ u32x2 pk4(f32x4 v) { u32x2 o; o.x = pk_bf16(v[0], v[1]); o.y = pk_bf16(v[2], v[3]); return o; }


#define XB_TMO      128
#define XB_XCNT(j)  (256  + 64 * (j))
#define XB_XSUB(j)  (1280 + 64 * (j))
#define XB_XGEN(j)  (2304 + 64 * (j))
#define XB_TOP      3328
#define XB_TOPGEN   3392
#define XCD_BAR_WORDS 3456
#define XB_SPIN_CAP (1u << 22)
__device__ __forceinline__ unsigned xb_ld(unsigned* p)              { return __hip_atomic_load(p, __ATOMIC_RELAXED, __HIP_MEMORY_SCOPE_AGENT); }
__device__ __forceinline__ unsigned xb_add(unsigned* p, unsigned v) { return __hip_atomic_fetch_add(p, v, __ATOMIC_RELAXED, __HIP_MEMORY_SCOPE_AGENT); }
__device__ __forceinline__ unsigned xb_xcc_id() { return (unsigned)__builtin_amdgcn_s_getreg((3 << 11) | 20) & 0xFu; }
#define XB_SPIN(cond, bar) do { unsigned _sp = 0; while (cond) { __builtin_amdgcn_s_sleep(1); \
    if ((++_sp & 255u) == 0u) { if (xb_ld(&(bar)[XB_TMO])) break; if (_sp > XB_SPIN_CAP) { atomicAdd(&(bar)[XB_TMO], 1u); break; } } } } while (0)
struct XcdBarrier { unsigned* bar; unsigned x; volatile LAS unsigned* st; };
__device__ __forceinline__ XcdBarrier xcd_barrier_post(unsigned* bar, volatile LAS unsigned* st) {
    XcdBarrier b; b.bar = bar; b.x = xb_xcc_id(); b.st = st;
    if (threadIdx.x == 0) (void)xb_add(&bar[XB_XCNT(b.x)], 1u);
    return b;
}
__device__ __forceinline__ void xcd_barrier_complete(unsigned* bar, unsigned x, unsigned& nloc, unsigned& nx) {
    const unsigned G = gridDim.x * gridDim.y * gridDim.z;
    unsigned sum, cnt, mine, sp = 0u;
    for (;;) {
        sum = 0u; cnt = 0u; mine = 0u;
#pragma unroll
        for (unsigned j = 0; j < 16; ++j) { const unsigned c = xb_ld(&bar[XB_XCNT(j)]); sum += c; cnt += (c > 0u) ? 1u : 0u; mine = (j == x) ? c : mine; }
        if (sum == G) break;
        __builtin_amdgcn_s_sleep(1);
        if ((++sp & 255u) == 0u) { if (xb_ld(&bar[XB_TMO])) break; if (sp > XB_SPIN_CAP) { atomicAdd(&bar[XB_TMO], 1u); break; } }
    }
    nloc = mine > 0u ? mine : 1u; nx = cnt > 0u ? cnt : 1u;
}
__device__ __forceinline__ void xcd_barrier(const XcdBarrier& b) {
    asm volatile("s_waitcnt vmcnt(0)" ::: "memory");
    __syncthreads();
    if (threadIdx.x == 0) {
        unsigned* bar = b.bar;
        __builtin_amdgcn_s_waitcnt(0);
        unsigned nloc = b.st[0], nx = b.st[1];
        if (nloc == 0u) { xcd_barrier_complete(bar, b.x, nloc, nx); b.st[0] = nloc; b.st[1] = nx; }
        const unsigned old = xb_add(&bar[XB_XSUB(b.x)], 1u);
        const unsigned gen = old / nloc;
        if (old + 1u == (gen + 1u) * nloc) {
            __builtin_amdgcn_fence(__ATOMIC_RELEASE, "agent");
            asm volatile("s_waitcnt vmcnt(0)" ::: "memory");
            const unsigned og = xb_add(&bar[XB_TOP], 1u);
            const unsigned tg = og / nx;
            if (og + 1u == (tg + 1u) * nx) xb_add(&bar[XB_TOPGEN], 1u);
            else XB_SPIN(xb_ld(&bar[XB_TOPGEN]) == tg, bar);
            __builtin_amdgcn_fence(__ATOMIC_ACQUIRE, "agent");
            xb_add(&bar[XB_XGEN(b.x)], 1u);
            asm volatile("s_waitcnt vmcnt(0)" ::: "memory");
        } else {
            XB_SPIN(xb_ld(&bar[XB_XGEN(b.x)]) == gen, bar);
            __builtin_amdgcn_fence(__ATOMIC_ACQUIRE, "agent");
            asm volatile("s_waitcnt vmcnt(0)" ::: "memory");
        }
    }
    __syncthreads();
}

namespace pg8 {
constexpr int BM = 256, BK = 64, HALF = 128, HTB = HALF * BK * 2, STAGE_BYTES = 8 * HTB, NXCD = 8, WGM = 8;
__device__ __forceinline__ int lds_byte(int r, int c) { const int st = (r >> 4) * 2 + (c >> 5), rr = r & 15, cc = c & 31, ob = rr * 64 + cc * 2; return st * 1024 + (ob ^ (((ob >> 9) & 1) << 5)); }
__device__ __forceinline__ void stage_rc(int b, int& R, int& C) { const int st = b / 1024, sb = b % 1024, swz = sb ^ (((sb >> 9) & 1) << 5); R = (st >> 1) * 16 + swz / 64; C = (st & 1) * 32 + (swz % 64) / 2; }
struct Unit { int pm, pn; };
struct Gemm { const bf16_t* A; const bf16_t* Bt; int M, N, K; };
struct StaticOrder {
    int nM, nN, nwg, G, c;
    __device__ void init(int M, int N, int G_, int c_) { nM = M / BM; nN = N / BM; nwg = nM * nN; G = G_; c = c_; }
    __device__ bool next(int i, Unit& u) const {
        const long L = (long)i * G + c; if (L >= nwg) return false;
        int wgid = (int)L; { const int q = nwg / NXCD, r = nwg % NXCD, xcd = wgid % NXCD, off = wgid / NXCD; wgid = (xcd < r ? xcd * (q + 1) : r * (q + 1) + (xcd - r) * q) + off; }
        const int nig = WGM * nN, gid = wgid / nig, fm = gid * WGM, gsz = (nM - fm) < WGM ? (nM - fm) : WGM;
        u.pm = fm + ((wgid % nig) % gsz); u.pn = (wgid % nig) / gsz; return true;
    }
};

template <class Epi>
__device__ __forceinline__ void gemm_phase(LAS unsigned char* lds, const Gemm g, const StaticOrder& S, const Epi& E) {
    const int tid = threadIdx.x, wid = __builtin_amdgcn_readfirstlane(tid >> 6), lane = tid & 63, wr = wid >> 2, wc = wid & 3, fr = lane & 15, fq = lane >> 4;
    int K_ = g.K; asm volatile("" : "+s"(K_));
    const int K = K_, nt = K / BK;
    unsigned voffA[2];
#pragma unroll
    for (int i = 0; i < 2; ++i) { int R, C; stage_rc(tid * 16 + i * 8192, R, C); voffA[i] = (unsigned)(R * K + C) * 2u; }
    const size_t kstep = (size_t)(BK * 2);
    const size_t hstep = (size_t)HALF * K * 2;
    const size_t tstep = 2 * hstep;
    const unsigned ldsw = (unsigned)wid * 1024u;
    const int aoff = lds_byte(wr * 64 + fr, fq * 8), boff = lds_byte(wc * 32 + fr, fq * 8);
#define PG8_SA(b, h) (((b) * 2 + (h)) * HTB)
#define PG8_SB(b, h) ((4 + (b) * 2 + (h)) * HTB)
#define PG8_STAGE(bufoff, gbase, voff) do { _Pragma("unroll") for (int _i = 0; _i < 2; ++_i) \
        __builtin_amdgcn_global_load_lds((const unsigned*)((const char*)(gbase) + (voff)[_i]), (LAS unsigned*)(lds + (bufoff) + ldsw + _i * 8192), 16, 0, 0); } while (0)
#define PG8_LDA(dst, b, h) do { _Pragma("unroll") for (int m = 0; m < 4; ++m) _Pragma("unroll") for (int k = 0; k < 2; ++k) dst[m][k] = *(const LAS bf16x8*)(lds + PG8_SA(b, h) + aoff + m * 2048 + k * 1024); } while (0)
#define PG8_LDB(dst, b, h) do { _Pragma("unroll") for (int n = 0; n < 2; ++n) _Pragma("unroll") for (int k = 0; k < 2; ++k) dst[n][k] = *(const LAS bf16x8*)(lds + PG8_SB(b, h) + boff + n * 2048 + k * 1024); } while (0)
#define PG8_MMA(ai, bj, At, Bt) do { __builtin_amdgcn_s_setprio(1); _Pragma("unroll") for (int m = 0; m < 4; ++m) _Pragma("unroll") for (int n = 0; n < 2; ++n) _Pragma("unroll") for (int k = 0; k < 2; ++k) \
        acc[ai][bj][m][n] = __builtin_amdgcn_mfma_f32_16x16x32_bf16(Bt[n][k], At[m][k], acc[ai][bj][m][n], 0, 0, 0); __builtin_amdgcn_s_setprio(0); } while (0)
#define PG8_WAIT_V(n) asm volatile("s_waitcnt vmcnt(" #n ")" ::: "memory")
#define PG8_WAIT_L(n) asm volatile("s_waitcnt lgkmcnt(" #n ")" ::: "memory")
#define PG8_BAR __builtin_amdgcn_s_barrier()
#define PG8_SCHED __builtin_amdgcn_sched_barrier(0)
    Unit cur, nxt; int ui = 0;
    if (!S.next(0, cur)) return;
    f32x4 acc[2][2][4][2];
#pragma unroll
    for (int a = 0; a < 2; ++a)
#pragma unroll
        for (int b = 0; b < 2; ++b)
#pragma unroll
            for (int m = 0; m < 4; ++m)
#pragma unroll
                for (int n = 0; n < 2; ++n) acc[a][b][m][n] = (f32x4){0.f, 0.f, 0.f, 0.f};
    bf16x8 At[4][2], B0[2][2], B1[2][2];
    const char* cA = (const char*)g.A + (size_t)cur.pm * tstep; const char* cB = (const char*)g.Bt + (size_t)cur.pn * tstep;
    PG8_STAGE(PG8_SB(0, 0), cB, voffA); PG8_STAGE(PG8_SA(0, 0), cA, voffA); PG8_STAGE(PG8_SB(0, 1), cB + hstep, voffA); PG8_STAGE(PG8_SA(0, 1), cA + hstep, voffA);
    if (wr == 1) PG8_BAR;
    PG8_WAIT_V(4); PG8_BAR;
    PG8_STAGE(PG8_SB(1, 0), cB + kstep, voffA); PG8_STAGE(PG8_SA(1, 0), cA + kstep, voffA); PG8_STAGE(PG8_SB(1, 1), cB + hstep + kstep, voffA);
    PG8_WAIT_V(6); PG8_BAR;
    for (;;) {
        const bool has_next = S.next(ui + 1, nxt);
        const char* nA = has_next ? (const char*)g.A + (size_t)nxt.pm * tstep : cA; const char* nB = has_next ? (const char*)g.Bt + (size_t)nxt.pn * tstep : cB;
        for (int t = 0; t < nt; t += 2) {
            const bool last = (t == nt - 2);
            const char* a1 = cA + (size_t)(t + 1) * kstep;
            const char* a2 = last ? nA : cA + (size_t)(t + 2) * kstep; const char* b2 = last ? nB : cB + (size_t)(t + 2) * kstep;
            const char* a3 = a2 + kstep; const char* b3 = b2 + kstep;
            PG8_LDB(B0, 0, 0); PG8_SCHED; PG8_LDA(At, 0, 0); PG8_STAGE(PG8_SA(1, 1), a1 + hstep, voffA);
            PG8_WAIT_L(8); PG8_BAR; PG8_WAIT_L(0); PG8_MMA(0, 0, At, B0); PG8_BAR; PG8_SCHED;
            PG8_LDB(B1, 0, 1); PG8_STAGE(PG8_SB(0, 0), b2, voffA);
            PG8_BAR; PG8_WAIT_L(0); PG8_MMA(0, 1, At, B1); PG8_BAR;
            PG8_LDA(At, 0, 1); PG8_STAGE(PG8_SA(0, 0), a2, voffA);
            PG8_BAR; PG8_WAIT_L(0); PG8_MMA(1, 0, At, B0); PG8_BAR; PG8_SCHED;
            PG8_STAGE(PG8_SB(0, 1), b2 + hstep, voffA);
            PG8_WAIT_V(6); PG8_BAR; PG8_MMA(1, 1, At, B1); PG8_BAR;
            PG8_LDB(B0, 1, 0); PG8_SCHED; PG8_LDA(At, 1, 0); PG8_STAGE(PG8_SA(0, 1), a2 + hstep, voffA);
            PG8_WAIT_L(8); PG8_BAR; PG8_WAIT_L(0); PG8_MMA(0, 0, At, B0); PG8_BAR; PG8_SCHED;
            PG8_LDB(B1, 1, 1); PG8_STAGE(PG8_SB(1, 0), b3, voffA);
            PG8_BAR; PG8_WAIT_L(0); PG8_MMA(0, 1, At, B1); PG8_BAR;
            PG8_LDA(At, 1, 1); PG8_STAGE(PG8_SA(1, 0), a3, voffA);
            PG8_BAR; PG8_WAIT_L(0); PG8_MMA(1, 0, At, B0); PG8_BAR; PG8_SCHED;
            PG8_STAGE(PG8_SB(1, 1), b3 + hstep, voffA);
            PG8_WAIT_V(6); PG8_BAR; PG8_MMA(1, 1, At, B1); PG8_BAR;
        }
        if constexpr (Epi::AFTER_DRAIN) { if (has_next) epi_main(E, acc, cur, wr, wc, fr, fq); }
        else epi_main(E, acc, cur, wr, wc, fr, fq);
        if (!has_next) break;
#pragma unroll
        for (int a = 0; a < 2; ++a)
#pragma unroll
            for (int b = 0; b < 2; ++b)
#pragma unroll
                for (int m = 0; m < 4; ++m)
#pragma unroll
                    for (int n = 0; n < 2; ++n) acc[a][b][m][n] = (f32x4){0.f, 0.f, 0.f, 0.f};
        cur = nxt; cA = nA; cB = nB; ++ui;
    }
    PG8_WAIT_V(0);
    if (wr == 0) PG8_BAR;
    PG8_BAR;
    if constexpr (Epi::AFTER_DRAIN) E.fused(acc, cur, wr, wc, fr, fq);
#undef PG8_SA
#undef PG8_SB
#undef PG8_STAGE
#undef PG8_LDA
#undef PG8_LDB
#undef PG8_MMA
#undef PG8_WAIT_V
#undef PG8_WAIT_L
#undef PG8_BAR
#undef PG8_SCHED
}
}
using pg8::Unit;

__device__ __forceinline__ void ln_stats(const float* st, int r, float& mu, float& rstd) {
    const float s = st[2 * r], q = st[2 * r + 1];
    mu = s * (1.0f / DM); const float var = q * (1.0f / DM) - mu * mu; rstd = rsqrtf(var + LN_EPS);
}
struct EpiIn {
    static constexpr bool GU = false, STATS = false, AFTER_DRAIN = false;
    bf16_t* qkvb; bf16_t* ubuf; float* out;
    struct Row {};
    __device__ __forceinline__ Row row_begin(int) const { return Row{}; }
    __device__ __forceinline__ f32x4 load(const Row&, int, int) const { return (f32x4){0.f, 0.f, 0.f, 0.f}; }
    __device__ __forceinline__ void vec(const Row&, int r, int c, f32x4 v, f32x4, float&, float&) const {
        const int seg = c >> 9;
        if (seg == 0) {
            *(u32x2*)(qkvb + (size_t)r * 1536 + c) = pk4(v * (0.125f * 1.4426950408889634f));
        } else if (seg < 3) {
            *(u32x2*)(qkvb + (size_t)r * 1536 + c) = pk4(v);
            const int isv = seg == 2; const int cc = c & 511;
            float* dst = (r < MP) ? out + (isv ? OFF_VP : OFF_KP) + (size_t)r * 512 + cc
                                  : out + (isv ? OFF_VS : OFF_KS) + (size_t)(r - MP) * 512 + cc;
            __builtin_nontemporal_store(v, (f32x4*)dst);
        } else {
            const int cc = c & 511;
            *(u32x2*)(ubuf + (size_t)r * 512 + cc) = pk4(v);
            if (r < MP) { const int t = r & (SEQ - 1), b = r >> 12; if (t >= SEQ - 15) *(f32x4*)(out + OFF_PP + (size_t)(b * 15 + t - (SEQ - 15)) * 512 + cc) = v; }
            else { const int rr = r - MP, b = rr >> 5, t = rr & 31; if (t >= DSEQ - 15) *(f32x4*)(out + OFF_PS + (size_t)(b * 15 + t - (DSEQ - 15)) * 512 + cc) = v; }
        }
    }
    __device__ __forceinline__ void row_end(int, float, float) const {}
};
struct EpiOut {
    static constexpr bool GU = false, STATS = true, AFTER_DRAIN = false;
    const bf16_t* xb; bf16_t* pb16; float* st;
    struct Row {};
    __device__ __forceinline__ Row row_begin(int) const { return Row{}; }
    __device__ __forceinline__ f32x4 load(const Row&, int r, int c) const { return up4(*(const u32x2*)(xb + (size_t)r * DM + c)); }
    __device__ __forceinline__ void vec(const Row&, int r, int c, f32x4 v, f32x4 xv, float& s, float& q) const {
        const f32x4 pv = xv * ALPHA + v;
        *(u32x2*)(pb16 + (size_t)r * DM + c) = pk4(pv);
        s += (pv[0] + pv[1]) + (pv[2] + pv[3]);
        q += (pv[0] * pv[0] + pv[1] * pv[1]) + (pv[2] * pv[2] + pv[3] * pv[3]);
    }
    __device__ __forceinline__ void row_end(int r, float s, float q) const { atomicAdd(st + 2 * r, s); atomicAdd(st + 2 * r + 1, q); }
};
struct EpiGU {
    static constexpr bool GU = true, STATS = false, AFTER_DRAIN = false;
    const float* st; const float* cs; const float* bw; bf16_t* hid;
    struct Row { float mu, rstd; };
    __device__ __forceinline__ Row row_begin(int r) const { Row R; ln_stats(st, r, R.mu, R.rstd); return R; }
    __device__ __forceinline__ void vec2(const Row& R, int r, int ff, int cgi, f32x4 ga, f32x4 ua) const {
        const f32x4 csg = *(const f32x4*)(cs + cgi), csu = *(const f32x4*)(cs + cgi + 128);
        const f32x4 bwg = *(const f32x4*)(bw + cgi), bwu = *(const f32x4*)(bw + cgi + 128);
        vec2c(R, r, ff, ga, ua, csg, csu, bwg, bwu);
    }
    __device__ __forceinline__ void vec2c(const Row& R, int r, int ff, f32x4 ga, f32x4 ua, f32x4 csg, f32x4 csu, f32x4 bwg, f32x4 bwu) const {
        const f32x4 gt = (ga - csg * R.mu) * R.rstd + bwg;
        const f32x4 up = (ua - csu * R.mu) * R.rstd + bwu;
        f32x4 hv;
#pragma unroll
        for (int e = 0; e < 4; ++e) hv[e] = gt[e] * __builtin_amdgcn_rcpf(1.0f + __expf(-gt[e])) * up[e];
        *(u32x2*)(hid + (size_t)r * DFF + ff) = pk4(hv);
    }
};
struct EpiDown {
    static constexpr bool GU = false, STATS = true, AFTER_DRAIN = false;
    const bf16_t* pb16; const float* st1; const float* g1; const float* b1; float* st2; float* yo;
    struct Row { float mu, rstd; };
    __device__ __forceinline__ Row row_begin(int r) const { Row R; ln_stats(st1, r, R.mu, R.rstd); return R; }
    __device__ __forceinline__ f32x4 load(const Row&, int r, int c) const { return up4(*(const u32x2*)(pb16 + (size_t)r * DM + c)); }
    __device__ __forceinline__ void vec(const Row& R, int r, int c, f32x4 v, f32x4 pv, float& s, float& q) const {
        const f32x4 gv = *(const f32x4*)(g1 + c), bv = *(const f32x4*)(b1 + c);
        const f32x4 x1 = (pv - R.mu) * R.rstd * gv + bv;
        const f32x4 o = x1 * ALPHA + v;
        *(f32x4*)(yo + (size_t)r * DM + c) = o;
        s += (o[0] + o[1]) + (o[2] + o[3]);
        q += (o[0] * o[0] + o[1] * o[1]) + (o[2] * o[2] + o[3] * o[3]);
    }
    __device__ __forceinline__ void row_end(int r, float s, float q) const { atomicAdd(st2 + 2 * r, s); atomicAdd(st2 + 2 * r + 1, q); }
};

__device__ __forceinline__ void panel_meet(unsigned* cnt, unsigned want) {
    asm volatile("s_waitcnt vmcnt(0)" ::: "memory");
    __syncthreads();
    if (threadIdx.x == 0) {
        __builtin_amdgcn_fence(__ATOMIC_RELEASE, "agent");
        asm volatile("s_waitcnt vmcnt(0)" ::: "memory");
        __hip_atomic_fetch_add(cnt, 1u, __ATOMIC_RELAXED, __HIP_MEMORY_SCOPE_AGENT);
        unsigned sp = 0;
        while (__hip_atomic_load(cnt, __ATOMIC_RELAXED, __HIP_MEMORY_SCOPE_AGENT) < want) { __builtin_amdgcn_s_sleep(1); if (++sp > (1u << 24)) break; }
    }
    __syncthreads();
}
__device__ __forceinline__ void ln_stats_agent(float* st, int r, float& mu, float& rstd) {
    const float s = __hip_atomic_load(st + 2 * r, __ATOMIC_RELAXED, __HIP_MEMORY_SCOPE_AGENT), q = __hip_atomic_load(st + 2 * r + 1, __ATOMIC_RELAXED, __HIP_MEMORY_SCOPE_AGENT);
    mu = s * (1.0f / DM); const float var = q * (1.0f / DM) - mu * mu; rstd = rsqrtf(var + LN_EPS);
}
struct EpiDownF {
    static constexpr bool GU = false, STATS = true, AFTER_DRAIN = true;
    const bf16_t* pb16; const float* st1; const float* g1; const float* b1; float* st2; float* yo; const float* g2; const float* b2; unsigned* cnt;
    struct Row { float mu, rstd; };
    __device__ __forceinline__ Row row_begin(int r) const { Row R; ln_stats(st1, r, R.mu, R.rstd); return R; }
    __device__ __forceinline__ f32x4 load(const Row&, int r, int c) const { return up4(*(const u32x2*)(pb16 + (size_t)r * DM + c)); }
    __device__ __forceinline__ f32x4 pre2(const Row& R, int c, f32x4 v, f32x4 pv, float& s, float& q) const {
        const f32x4 gv = *(const f32x4*)(g1 + c), bv = *(const f32x4*)(b1 + c);
        const f32x4 x1 = (pv - R.mu) * R.rstd * gv + bv;
        const f32x4 o = x1 * ALPHA + v;
        s += (o[0] + o[1]) + (o[2] + o[3]);
        q += (o[0] * o[0] + o[1] * o[1]) + (o[2] * o[2] + o[3] * o[3]);
        return o;
    }
    __device__ __forceinline__ void vec(const Row& R, int r, int c, f32x4 v, f32x4 pv, float& s, float& q) const { *(f32x4*)(yo + (size_t)r * DM + c) = pre2(R, c, v, pv, s, q); }
    __device__ __forceinline__ void row_end(int r, float s, float q) const { atomicAdd(st2 + 2 * r, s); atomicAdd(st2 + 2 * r + 1, q); }
    __device__ __forceinline__ void fused(f32x4 (&acc)[2][2][4][2], const Unit& u, int wr, int wc, int fr, int fq) const {
        const int rbase = u.pm * 256 + wr * 64 + fr, cbase = u.pn * 256 + wc * 32 + 4 * fq;
        {
            Row Rn = row_begin(rbase);
            f32x4 inn[4];
#pragma unroll
            for (int j = 0; j < 4; ++j) inn[j] = load(Rn, rbase, cbase + (j >> 1) * 128 + (j & 1) * 16);
#pragma unroll
            for (int g = 0; g < 8; ++g) {
                const int ai = g >> 2, m = g & 3, r = rbase + ai * 128 + m * 16;
                const Row R = Rn;
                f32x4 in[4];
#pragma unroll
                for (int j = 0; j < 4; ++j) in[j] = inn[j];
                if (g < 7) {
                    const int r2 = rbase + ((g + 1) >> 2) * 128 + ((g + 1) & 3) * 16;
                    Rn = row_begin(r2);
#pragma unroll
                    for (int j = 0; j < 4; ++j) inn[j] = load(Rn, r2, cbase + (j >> 1) * 128 + (j & 1) * 16);
                }
                float s = 0.f, q = 0.f;
#pragma unroll
                for (int j = 0; j < 4; ++j) acc[ai][j >> 1][m][j & 1] = pre2(R, cbase + (j >> 1) * 128 + (j & 1) * 16, acc[ai][j >> 1][m][j & 1], in[j], s, q);
                s += __shfl_xor(s, 16); s += __shfl_xor(s, 32);
                q += __shfl_xor(q, 16); q += __shfl_xor(q, 32);
                if (fq == 0) row_end(r, s, q);
            }
        }
        panel_meet(cnt + 64 * u.pm, 4u);
        f32x4 gv[4], bv[4];
#pragma unroll
        for (int j = 0; j < 4; ++j) { const int c = cbase + (j >> 1) * 128 + (j & 1) * 16; gv[j] = *(const f32x4*)(g2 + c); bv[j] = *(const f32x4*)(b2 + c); }
        float mu8[8], rs8[8];
#pragma unroll
        for (int g = 0; g < 8; ++g) ln_stats_agent(st2, rbase + (g >> 2) * 128 + (g & 3) * 16, mu8[g], rs8[g]);
#pragma unroll
        for (int g = 0; g < 8; ++g) {
            const int ai = g >> 2, m = g & 3, r = rbase + ai * 128 + m * 16;
            const float mu = mu8[g], rstd = rs8[g];
#pragma unroll
            for (int j = 0; j < 4; ++j) __builtin_nontemporal_store((acc[ai][j >> 1][m][j & 1] - mu) * rstd * gv[j] + bv[j], (f32x4*)(yo + (size_t)r * DM + cbase + (j >> 1) * 128 + (j & 1) * 16));
        }
    }
    __device__ __forceinline__ void fused_mini(f32x4 (&acc)[2], int r, int rowblk, int c0, int fq) const {
        const Row R = row_begin(r);
        float s = 0.f, q = 0.f;
#pragma unroll
        for (int nb = 0; nb < 2; ++nb) acc[nb] = pre2(R, c0 + nb * 32, acc[nb], load(R, r, c0 + nb * 32), s, q);
        s += __shfl_xor(s, 16); s += __shfl_xor(s, 32);
        q += __shfl_xor(q, 16); q += __shfl_xor(q, 32);
        if (fq == 0) row_end(r, s, q);
        panel_meet(cnt + 64 * (64 + rowblk), 16u);
        float mu, rstd; ln_stats_agent(st2, r, mu, rstd);
#pragma unroll
        for (int nb = 0; nb < 2; ++nb) { const int c = c0 + nb * 32; *(f32x4*)(yo + (size_t)r * DM + c) = (acc[nb] - mu) * rstd * *(const f32x4*)(g2 + c) + *(const f32x4*)(b2 + c); }
    }
};

template <class Epi>
__device__ __forceinline__ void epi_main(const Epi& E, const f32x4 (&acc)[2][2][4][2], const Unit& u, int wr, int wc, int fr, int fq) {
    const int rbase = u.pm * 256 + wr * 64 + fr;
    if constexpr (Epi::GU) {
        f32x4 csg[2], csu[2], bwg[2], bwu[2];
#pragma unroll
        for (int n = 0; n < 2; ++n) {
            const int cgi = u.pn * 256 + wc * 32 + n * 16 + 4 * fq;
            csg[n] = *(const f32x4*)(E.cs + cgi); csu[n] = *(const f32x4*)(E.cs + cgi + 128);
            bwg[n] = *(const f32x4*)(E.bw + cgi); bwu[n] = *(const f32x4*)(E.bw + cgi + 128);
        }
        typename Epi::Row Rn = E.row_begin(rbase);
#pragma unroll
        for (int g = 0; g < 8; ++g) {
            const int ai = g >> 2, m = g & 3, r = rbase + ai * 128 + m * 16;
            const typename Epi::Row R = Rn;
            if (g < 7) Rn = E.row_begin(rbase + ((g + 1) >> 2) * 128 + ((g + 1) & 3) * 16);
#pragma unroll
            for (int n = 0; n < 2; ++n) E.vec2c(R, r, u.pn * 128 + wc * 32 + n * 16 + 4 * fq, acc[ai][0][m][n], acc[ai][1][m][n], csg[n], csu[n], bwg[n], bwu[n]);
        }
    } else {
        const int cbase = u.pn * 256 + wc * 32 + 4 * fq;
        typename Epi::Row Rn = E.row_begin(rbase);
        f32x4 inn[4];
#pragma unroll
        for (int j = 0; j < 4; ++j) inn[j] = E.load(Rn, rbase, cbase + (j >> 1) * 128 + (j & 1) * 16);
#pragma unroll
        for (int g = 0; g < 8; ++g) {
            const int ai = g >> 2, m = g & 3, r = rbase + ai * 128 + m * 16;
            const typename Epi::Row R = Rn;
            f32x4 in[4];
#pragma unroll
            for (int j = 0; j < 4; ++j) in[j] = inn[j];
            if (g < 7) {
                const int r2 = rbase + ((g + 1) >> 2) * 128 + ((g + 1) & 3) * 16;
                Rn = E.row_begin(r2);
#pragma unroll
                for (int j = 0; j < 4; ++j) inn[j] = E.load(Rn, r2, cbase + (j >> 1) * 128 + (j & 1) * 16);
            }
            float s = 0.f, q = 0.f;
#pragma unroll
            for (int j = 0; j < 4; ++j) E.vec(R, r, cbase + (j >> 1) * 128 + (j & 1) * 16, acc[ai][j >> 1][m][j & 1], in[j], s, q);
            if constexpr (Epi::STATS) {
                s += __shfl_xor(s, 16); s += __shfl_xor(s, 32);
                q += __shfl_xor(q, 16); q += __shfl_xor(q, 32);
                if (fq == 0) E.row_end(r, s, q);
            }
        }
    }
}

template <class Epi>
__device__ __forceinline__ void mini_gemm_tile(LAS unsigned char* lds, const bf16_t* __restrict__ A, const bf16_t* __restrict__ Bt, int K, int m0, int nt_idx, const Epi& E) {
    constexpr int LDT = 136;
    LAS bf16_t* As = (LAS bf16_t*)lds;
    LAS bf16_t* Bs = As + 2 * 64 * LDT;
    const int tid = threadIdx.x, lane = tid & 63, wave = tid >> 6, wr = wave >> 1, wc = wave & 1, fr = lane & 15, fq = lane >> 4;
    const int lrow = tid >> 3, lcol = (tid & 7) * 8;
    int brow;
    if constexpr (Epi::GU) brow = (nt_idx >> 2) * 256 + (lrow >> 5) * 128 + (nt_idx & 3) * 32 + (lrow & 31); else brow = nt_idx * 64 + lrow;
    const bf16_t* ap = A + (size_t)(m0 + lrow) * K + lcol;
    const bf16_t* bp = Bt + (size_t)brow * K + lcol;
    u32x4 ra[4], rb[4], rc[4], rd[4];
#define MG_LOAD(r, kt) do { r[0] = *(const u32x4*)(ap + (kt) * 128); r[1] = *(const u32x4*)(ap + (kt) * 128 + 64); r[2] = *(const u32x4*)(bp + (kt) * 128); r[3] = *(const u32x4*)(bp + (kt) * 128 + 64); } while (0)
#define MG_STORE(r, buf) do { *(LAS u32x4*)(As + ((buf) * 64 + lrow) * LDT + lcol) = r[0]; *(LAS u32x4*)(As + ((buf) * 64 + lrow) * LDT + lcol + 64) = r[1]; \
                              *(LAS u32x4*)(Bs + ((buf) * 64 + lrow) * LDT + lcol) = r[2]; *(LAS u32x4*)(Bs + ((buf) * 64 + lrow) * LDT + lcol + 64) = r[3]; } while (0)
#define MG_COMPUTE(buf) do { _Pragma("unroll") for (int ks = 0; ks < 4; ++ks) { \
        const bf16x8 af = *(const LAS bf16x8*)(As + ((buf) * 64 + wr * 16 + fr) * LDT + ks * 32 + fq * 8); \
        _Pragma("unroll") for (int nb = 0; nb < 2; ++nb) { const bf16x8 bfr = *(const LAS bf16x8*)(Bs + ((buf) * 64 + nb * 32 + wc * 16 + fr) * LDT + ks * 32 + fq * 8); \
            acc[nb] = __builtin_amdgcn_mfma_f32_16x16x32_bf16(bfr, af, acc[nb], 0, 0, 0); } } } while (0)
#define MG_STEP(r, kt_, buf) do { MG_STORE(r, buf); __syncthreads(); if ((kt_) + 4 < nkt) MG_LOAD(r, (kt_) + 4); MG_COMPUTE(buf); } while (0)
    f32x4 acc[2] = {(f32x4){0.f, 0.f, 0.f, 0.f}, (f32x4){0.f, 0.f, 0.f, 0.f}};
    const int nkt = K / 128;
    MG_LOAD(ra, 0); MG_LOAD(rb, 1); MG_LOAD(rc, 2); MG_LOAD(rd, 3);
    int kt = 0;
    for (; kt + 4 <= nkt; kt += 4) { MG_STEP(ra, kt, 0); MG_STEP(rb, kt + 1, 1); MG_STEP(rc, kt + 2, 0); MG_STEP(rd, kt + 3, 1); }
    if (kt < nkt) { MG_STEP(ra, kt, 0); MG_STEP(rb, kt + 1, 1); }
    __syncthreads();
#undef MG_STEP
#undef MG_LOAD
#undef MG_STORE
#undef MG_COMPUTE
    const int r = m0 + wr * 16 + fr;
    if constexpr (Epi::AFTER_DRAIN) { E.fused_mini(acc, r, (m0 - MP) >> 6, nt_idx * 64 + wc * 16 + 4 * fq, fq); return; }
    const typename Epi::Row R = E.row_begin(r);
    if constexpr (Epi::GU) {
        const int pn = nt_idx >> 2, ffo = (nt_idx & 3) * 32;
        E.vec2(R, r, pn * 128 + ffo + wc * 16 + 4 * fq, pn * 256 + ffo + wc * 16 + 4 * fq, acc[0], acc[1]);
    } else {
        float s = 0.f, q = 0.f;
#pragma unroll
        for (int nb = 0; nb < 2; ++nb) { const int c = nt_idx * 64 + nb * 32 + wc * 16 + 4 * fq; E.vec(R, r, c, acc[nb], E.load(R, r, c), s, q); }
        if constexpr (Epi::STATS) {
            s += __shfl_xor(s, 16); s += __shfl_xor(s, 32);
            q += __shfl_xor(q, 16); q += __shfl_xor(q, 32);
            if (fq == 0) E.row_end(r, s, q);
        }
    }
}
template <class Epi>
__device__ __forceinline__ void mini_gemm_phase(LAS unsigned char* lds, const bf16_t* A, const bf16_t* Bt, int K, int ntiles_n, int wg0, int nwg, const Epi& E) {
    const int me = (int)blockIdx.x - wg0;
    if (me < 0 || me >= nwg) return;
    for (int it = me; it < 4 * ntiles_n; it += nwg) mini_gemm_tile(lds, A, Bt, K, MP + (it & 3) * 64, it >> 2, E);
}

__device__ __forceinline__ void transpose_item(const float* __restrict__ src, int K, int N, int n0, bf16_t* __restrict__ dst, int ldd,
                                               const float* __restrict__ gs, const float* __restrict__ bv, float* cs_out, float* bw_out, LAS float* tile) {
    const int tid = threadIdx.x, ln = tid & 63, lr = tid >> 6;
    const int nt = K / 64;
    float cur[8], nxt[8];
#pragma unroll
    for (int i = 0; i < 8; ++i) cur[i] = src[(size_t)(lr + 8 * i) * N + n0 + ln];
    float csp = 0.f, bwp = 0.f;
    for (int t = 0; t < nt; ++t) {
        if (t + 1 < nt) {
#pragma unroll
            for (int i = 0; i < 8; ++i) nxt[i] = src[(size_t)((t + 1) * 64 + lr + 8 * i) * N + n0 + ln];
        }
        LAS float* tl = tile + (t & 1) * (64 * 65);
#pragma unroll
        for (int i = 0; i < 8; ++i) {
            const int k = t * 64 + lr + 8 * i;
            const float g = gs ? gs[k] : 1.0f; const float b = bv ? bv[k] : 0.0f;
            const float w = bf2f(f2bf(cur[i] * g));
            csp += w; bwp += b * cur[i];
            tl[(lr + 8 * i) * 65 + ln] = w;
        }
        __syncthreads();
#pragma unroll
        for (int i = 0; i < 8; ++i) {
            const int n = lr + 8 * i;
            dst[(size_t)n * ldd + t * 64 + ln] = f2bf(tl[ln * 65 + n]);
        }
#pragma unroll
        for (int i = 0; i < 8; ++i) cur[i] = nxt[i];
    }
    __syncthreads();
    if (cs_out) {
        LAS float* red = tile;
        red[lr * 64 + ln] = csp; red[512 + lr * 64 + ln] = bwp;
        __syncthreads();
        if (tid < 64) {
            float a = 0.f, b = 0.f;
#pragma unroll
            for (int i = 0; i < 8; ++i) { a += red[i * 64 + tid]; b += red[512 + i * 64 + tid]; }
            cs_out[tid] = a; bw_out[tid] = b;
        }
        __syncthreads();
    }
}

__device__ void phase0(const Params& p, LAS unsigned char* lds) {
    const int tid = threadIdx.x, nb = gridDim.x, bid = blockIdx.x;
    LAS float* tile = (LAS float*)lds;
    bf16_t* WinT = (bf16_t*)(p.ws + WS_WIN); bf16_t* WoutT = (bf16_t*)(p.ws + WS_WOUT); bf16_t* WguT = (bf16_t*)(p.ws + WS_WGU); bf16_t* WdT = (bf16_t*)(p.ws + WS_WD);
    bf16_t* pwT = (bf16_t*)(p.ws + WS_PWT); float* cs = (float*)(p.ws + WS_CS); float* bw = (float*)(p.ws + WS_BW);
    for (int item = bid; item < 160; item += nb) {
        if (item < 32) { const int n0 = item * 64; transpose_item(p.w_in, DM, NIN, n0, WinT + (size_t)n0 * DM, DM, nullptr, nullptr, nullptr, nullptr, tile); }
        else if (item < 48) { const int n0 = (item - 32) * 64; transpose_item(p.w_out, DM, DM, n0, WoutT + (size_t)n0 * DM, DM, nullptr, nullptr, nullptr, nullptr, tile); }
        else if (item < 136) {
            const int isu = item >= 92; const int n0 = (item - (isu ? 92 : 48)) * 64;
            const int drow = (n0 >> 7) * 256 + isu * 128 + (n0 & 127);
            transpose_item(isu ? p.wu : p.wg, DM, DFF, n0, WguT + (size_t)drow * DM, DM, p.ln1g, p.ln1b, cs + drow, bw + drow, tile);
        }
        else if (item < 152) { const int n0 = (item - 136) * 64; transpose_item(p.wd, DFF, DM, n0, WdT + (size_t)n0 * DFF, DFF, nullptr, nullptr, nullptr, nullptr, tile); }
        else { const int j = item - 152, g = j >> 1, n0 = (j & 1) * 64; transpose_item(p.pool_w + (size_t)g * 16384, 128, 128, n0, pwT + (size_t)g * 16384 + (size_t)n0 * 128, 128, nullptr, nullptr, nullptr, nullptr, tile); }
    }
    {
        bf16_t* xb = (bf16_t*)(p.ws + WS_A);
        const size_t n8 = (size_t)MT * DM / 8, np8 = (size_t)MP * DM / 8;
        for (size_t i = (size_t)bid * 512 + tid; i < n8; i += (size_t)nb * 512) {
            const f32x4* s = (i < np8) ? (const f32x4*)p.xp + 2 * i : (const f32x4*)p.xs + 2 * (i - np8);
            const f32x4 a = __builtin_nontemporal_load(s), b = __builtin_nontemporal_load(s + 1);
            u32x4 o; o.x = pk_bf16(a[0], a[1]); o.y = pk_bf16(a[2], a[3]); o.z = pk_bf16(b[0], b[1]); o.w = pk_bf16(b[2], b[3]);
            ((u32x4*)xb)[i] = o;
        }
    }
    {
        float* st = (float*)(p.ws + WS_ST1);
        for (int i = bid * 512 + tid; i < MT * 4; i += nb * 512) st[i] = 0.f;
    }
}

__device__ __forceinline__ float softplus2_f(float z2) { return fmaxf(z2, 0.f) + __builtin_amdgcn_logf(1.0f + __builtin_amdgcn_exp2f(-fabsf(z2))); }

__device__ __forceinline__ void attn_tile_t(const bf16x8 (&Kf)[2][2], const bf16x8 (&Qf)[2][2], LAS unsigned short* vt, f32x4 (&O)[2][4], float (&R)[2], bool DIAG, int c16, int g) {
    bf16x8 Vf[4];
#pragma unroll
    for (int db = 0; db < 4; ++db) {
        const u32x2 lo = *(const LAS u32x2*)(vt + (db * 16 + c16) * 36 + g * 4);
        const u32x2 hi = *(const LAS u32x2*)(vt + (db * 16 + c16) * 36 + 16 + g * 4);
        u32x4 o; o.x = lo.x; o.y = lo.y; o.z = hi.x; o.w = hi.y;
        Vf[db] = __builtin_bit_cast(bf16x8, o);
    }
#pragma unroll
    for (int qb = 0; qb < 2; ++qb) {
        f32x4 z[2];
#pragma unroll
        for (int kb = 0; kb < 2; ++kb) {
            z[kb] = __builtin_amdgcn_mfma_f32_16x16x32_bf16(Kf[kb][0], Qf[qb][0], (f32x4){0.f, 0.f, 0.f, 0.f}, 0, 0, 0);
            z[kb] = __builtin_amdgcn_mfma_f32_16x16x32_bf16(Kf[kb][1], Qf[qb][1], z[kb], 0, 0, 0);
        }
        float sp[2][4], lb[2][4]; bool ok[2][4];
        const int qrel = qb * 16 + c16;
#pragma unroll
        for (int kb = 0; kb < 2; ++kb)
#pragma unroll
            for (int j = 0; j < 4; ++j) {
                const int krel = kb * 16 + g * 4 + j;
                ok[kb][j] = (!DIAG) || (krel < qrel);
                const float zz = z[kb][j]; const float sf = softplus2_f(zz);
                sp[kb][j] = ok[kb][j] ? sf : 0.f; lb[kb][j] = zz - sf;
            }
        float ex[2][4], tot[2], hg[2], bt[2];
#pragma unroll
        for (int kb = 0; kb < 2; ++kb) {
            ex[kb][3] = 0.f; ex[kb][2] = sp[kb][3]; ex[kb][1] = ex[kb][2] + sp[kb][2]; ex[kb][0] = ex[kb][1] + sp[kb][1];
            tot[kb] = ex[kb][0] + sp[kb][0];
            const float a1 = __shfl_xor(tot[kb], 16), a2 = __shfl_xor(tot[kb], 32), a3 = __shfl_xor(tot[kb], 48);
            hg[kb] = (g == 0) ? (a1 + a2 + a3) : (g == 1) ? (a2 + a3) : (g == 2) ? a1 : 0.f;
            bt[kb] = (tot[kb] + a1) + (a2 + a3);
        }
        float pr[2][4];
#pragma unroll
        for (int j = 0; j < 4; ++j) {
            const float af1 = R[qb] + hg[1] + ex[1][j];
            const float af0 = R[qb] + bt[1] + hg[0] + ex[0][j];
            pr[1][j] = ok[1][j] ? __builtin_amdgcn_exp2f(lb[1][j] - af1) : 0.f;
            pr[0][j] = ok[0][j] ? __builtin_amdgcn_exp2f(lb[0][j] - af0) : 0.f;
        }
        R[qb] += bt[0] + bt[1];
        u32x4 po; po.x = pk_bf16(pr[0][0], pr[0][1]); po.y = pk_bf16(pr[0][2], pr[0][3]); po.z = pk_bf16(pr[1][0], pr[1][1]); po.w = pk_bf16(pr[1][2], pr[1][3]);
        const bf16x8 Pf = __builtin_bit_cast(bf16x8, po);
#pragma unroll
        for (int db = 0; db < 4; ++db) O[qb][db] = __builtin_amdgcn_mfma_f32_16x16x32_bf16(Vf[db], Pf, O[qb][db], 0, 0, 0);
    }
}
__device__ __forceinline__ void attn_tile(const bf16x8 (&Kf)[2][2], const bf16x8 (&Qf)[2][2], LAS unsigned short* vt, f32x4 (&O)[2][4], float (&R)[2], bool diag, int c16, int g) {
    attn_tile_t(Kf, Qf, vt, O, R, diag, c16, g);
}
#define WAVE_LDS_SYNC() do { asm volatile("" ::: "memory"); __builtin_amdgcn_wave_barrier(); asm volatile("" ::: "memory"); } while (0)

__device__ __forceinline__ void attn_item(const Params& p, int item, const bf16_t* __restrict__ qkvb, bf16_t* __restrict__ concat, LAS unsigned short* vt, int lane) {
    const bool prompt = item < 4096;
    int b, h, qt;
    if (prompt) { qt = item & 127; h = (item >> 7) & 7; b = item >> 10; } else { const int s = item - 4096; h = s & 7; b = s >> 3; qt = 0; }
    const size_t rowq = (prompt ? (size_t)b * SEQ : (size_t)MP + b * DSEQ) + qt * 32;
    const int qpos0 = (prompt ? 0 : PAST) + qt * 32;
    const int c16 = lane & 15, g = lane >> 4;
    bf16x8 Qf[2][2];
#pragma unroll
    for (int qb = 0; qb < 2; ++qb)
#pragma unroll
        for (int dh = 0; dh < 2; ++dh) Qf[qb][dh] = *(const bf16x8*)(qkvb + (rowq + qb * 16 + c16) * 1536 + h * 64 + dh * 32 + g * 8);
    f32x4 O[2][4];
#pragma unroll
    for (int qb = 0; qb < 2; ++qb)
#pragma unroll
        for (int db = 0; db < 4; ++db) O[qb][db] = (f32x4){0.f, 0.f, 0.f, 0.f};
    float R[2] = {0.f, 0.f};
    const int key = lane >> 1, dhalf = (lane & 1) * 32;
#ifndef ATTN_PREFETCH
#define ATTN_PREFETCH 0
#endif
    if (ATTN_PREFETCH && prompt) {
        const bf16_t* kbase = qkvb + ((size_t)b * SEQ + c16) * 1536 + 512 + h * 64 + g * 8;
        const bf16_t* vbase = qkvb + ((size_t)b * SEQ + key) * 1536 + 1024 + h * 64 + dhalf;
        bf16x8 Kr[2][2], Vr[4];
#define AT_LOAD(kp0) do { _Pragma("unroll") for (int kb = 0; kb < 2; ++kb) _Pragma("unroll") for (int dh = 0; dh < 2; ++dh) Kr[kb][dh] = *(const bf16x8*)(kbase + (size_t)((kp0) + kb * 16) * 1536 + dh * 32); \
                           _Pragma("unroll") for (int i = 0; i < 4; ++i) Vr[i] = *(const bf16x8*)(vbase + (size_t)(kp0) * 1536 + i * 8); } while (0)
        AT_LOAD(qpos0);
        for (int kt = qpos0 >> 5; kt >= 0; --kt) {
            bf16x8 Kf[2][2];
#pragma unroll
            for (int kb = 0; kb < 2; ++kb)
#pragma unroll
                for (int dh = 0; dh < 2; ++dh) Kf[kb][dh] = Kr[kb][dh];
#pragma unroll
            for (int i = 0; i < 4; ++i)
#pragma unroll
                for (int e = 0; e < 8; ++e) vt[(dhalf + i * 8 + e) * 36 + key] = (unsigned short)Vr[i][e];
            if (kt > 0) AT_LOAD((kt - 1) << 5);
            WAVE_LDS_SYNC();
            attn_tile(Kf, Qf, vt, O, R, (kt << 5) == qpos0, c16, g);
            WAVE_LDS_SYNC();
            if (__all(fminf(R[0], R[1]) > R_EXIT)) break;
        }
#undef AT_LOAD
    } else {
        for (int kt = qpos0 >> 5; kt >= 0; --kt) {
            const int kp0 = kt << 5;
            bf16x8 Kf[2][2];
            if (prompt || kp0 >= PAST) {
                const size_t krow = prompt ? (size_t)b * SEQ + kp0 : (size_t)MP + b * DSEQ + (kp0 - PAST);
#pragma unroll
                for (int kb = 0; kb < 2; ++kb)
#pragma unroll
                    for (int dh = 0; dh < 2; ++dh) Kf[kb][dh] = *(const bf16x8*)(qkvb + (krow + kb * 16 + c16) * 1536 + 512 + h * 64 + dh * 32 + g * 8);
                const bf16_t* vp = qkvb + (krow + key) * 1536 + 1024 + h * 64 + dhalf;
#pragma unroll
                for (int i = 0; i < 4; ++i) {
                    const bf16x8 v = *(const bf16x8*)(vp + i * 8);
#pragma unroll
                    for (int e = 0; e < 8; ++e) vt[(dhalf + i * 8 + e) * 36 + key] = (unsigned short)v[e];
                }
            } else {
                const float* kp = p.ck + ((size_t)(b * PAST + kp0) * 8 + h) * 64;
#pragma unroll
                for (int kb = 0; kb < 2; ++kb)
#pragma unroll
                    for (int dh = 0; dh < 2; ++dh) {
                        const float* sp_ = kp + (size_t)(kb * 16 + c16) * 512 + dh * 32 + g * 8;
                        const f32x4 a = *(const f32x4*)sp_, bb = *(const f32x4*)(sp_ + 4);
                        u32x4 o; o.x = pk_bf16(a[0], a[1]); o.y = pk_bf16(a[2], a[3]); o.z = pk_bf16(bb[0], bb[1]); o.w = pk_bf16(bb[2], bb[3]);
                        Kf[kb][dh] = __builtin_bit_cast(bf16x8, o);
                    }
                const float* vp = p.cv + ((size_t)(b * PAST + kp0 + key) * 8 + h) * 64 + dhalf;
#pragma unroll
                for (int i = 0; i < 8; ++i) {
                    const f32x4 v = *(const f32x4*)(vp + i * 4);
#pragma unroll
                    for (int e = 0; e < 4; ++e) vt[(dhalf + i * 4 + e) * 36 + key] = f2bf(v[e]);
                }
            }
            WAVE_LDS_SYNC();
            attn_tile(Kf, Qf, vt, O, R, kp0 == qpos0, c16, g);
            WAVE_LDS_SYNC();
            if (__all(fminf(R[0], R[1]) > R_EXIT)) break;
        }
    }
#pragma unroll
    for (int qb = 0; qb < 2; ++qb)
#pragma unroll
        for (int db = 0; db < 4; ++db)
            *(u32x2*)(concat + (rowq + qb * 16 + c16) * DM + h * 64 + db * 16 + g * 4) = pk4(O[qb][db]);
}

template <int G>
__device__ __forceinline__ void pool_item_g(const Params& p, int tokblk, const bf16_t* __restrict__ ubuf, const bf16_t* __restrict__ pwT, bf16_t* __restrict__ concat, LAS bf16_t* dt, int lane) {
    constexpr int W = 2 << G;
    const int r0 = tokblk * 16;
    int t0, start; size_t rb; const float* hist;
    if (r0 < MP) { t0 = r0 & (SEQ - 1); rb = (size_t)(r0 - t0); start = 0; hist = nullptr; }
    else { const int rr = r0 - MP; const int b = rr >> 5; t0 = rr & 31; rb = (size_t)MP + b * DSEQ; start = PAST; hist = p.sp + (size_t)b * 15 * 512; }
    const int c16 = lane & 15, gq = lane >> 4;
    const bf16_t* wbase = pwT + (size_t)G * 16384 + (size_t)c16 * 128 + gq * 8;
    float v[2][15 + W];
#pragma unroll
    for (int half = 0; half < 2; ++half) {
        const int ch = G * 128 + half * 64 + lane;
#pragma unroll
        for (int i = 0; i < 15 + W; ++i) {
            const int t = t0 - (W - 1) + i;
            const int tc = (t >= 0) ? t : 0;
            const float xu = bf2f(ubuf[(rb + tc) * 512 + ch]);
            const float xh = (t < 0 && hist) ? hist[(size_t)(15 + t) * 512 + ch] : 0.f;
            v[half][i] = (t >= 0) ? xu : xh;
        }
    }
#pragma unroll
    for (int half = 0; half < 2; ++half) {
        float s = 0.f;
#pragma unroll
        for (int i = 0; i < W - 1; ++i) s += v[half][i];
#pragma unroll
        for (int i = 0; i < 16; ++i) {
            const float cur = v[half][W - 1 + i];
            s += cur;
            const int cnt = min(W, start + t0 + i + 1);
            const float d = s / (float)cnt - cur;
            dt[i * 136 + half * 64 + lane] = f2bf(d);
            s -= v[half][i];
        }
    }
    WAVE_LDS_SYNC();
    f32x4 acc[8];
    bf16x8 bfrag[4];
#pragma unroll
    for (int ks = 0; ks < 4; ++ks) bfrag[ks] = *(const LAS bf16x8*)(dt + c16 * 136 + ks * 32 + gq * 8);
    const bf16_t* wp = wbase;
    asm volatile("" : "+v"(wp));
    bf16x8 wa[8][4];
#pragma unroll
    for (int nb = 0; nb < 8; ++nb)
#pragma unroll
        for (int ks = 0; ks < 4; ++ks) wa[nb][ks] = *(const bf16x8*)(wp + (size_t)nb * 16 * 128 + ks * 32);
    asm volatile("" ::: "memory");
#pragma unroll
    for (int nb = 0; nb < 8; ++nb) {
        acc[nb] = (f32x4){0.f, 0.f, 0.f, 0.f};
#pragma unroll
        for (int ks = 0; ks < 4; ++ks) acc[nb] = __builtin_amdgcn_mfma_f32_16x16x32_bf16(wa[nb][ks], bfrag[ks], acc[nb], 0, 0, 0);
    }
    const int row = r0 + c16;
#pragma unroll
    for (int nb = 0; nb < 8; ++nb) {
        const int dout = G * 128 + nb * 16 + gq * 4;
        const f32x4 sc = *(const f32x4*)(p.pool_scale + dout);
        *(u32x2*)(concat + (size_t)row * DM + 512 + dout) = pk4(acc[nb] * sc);
    }
    WAVE_LDS_SYNC();
}

constexpr int P2_ITEMS = 8320, P2_PER_Q = P2_ITEMS / 8;
__device__ __forceinline__ void phase2(const Params& p, LAS unsigned char* lds, const bf16_t* qkvb, const bf16_t* ubuf, bf16_t* concat) {
    const int tid = threadIdx.x, wave = tid >> 6, lane = tid & 63;
    LAS unsigned short* wl = (LAS unsigned short*)(lds + wave * 4608);
    unsigned* ctr = (unsigned*)(p.ws + WS_BAR + 14336);
    const bf16_t* pwT = (const bf16_t*)(p.ws + WS_PWT);
#ifndef P2_STATIC
#define P2_STATIC 0
#endif
#if P2_STATIC
    for (int item = (int)blockIdx.x * 8 + wave; item < P2_ITEMS; item += (int)gridDim.x * 8) {
        {
#else
    const int q0 = blockIdx.x & 7;
    for (int qq = 0; qq < 8; ++qq) {
        const int qi = (q0 + qq) & 7;
        for (;;) {
            unsigned i = 0;
            if (lane == 0) i = __hip_atomic_fetch_add(ctr + qi * 64, 1u, __ATOMIC_RELAXED, __HIP_MEMORY_SCOPE_AGENT);
            i = (unsigned)__builtin_amdgcn_readfirstlane((int)i);
            if (i >= (unsigned)P2_PER_Q) break;
            const int seq = (int)i * 8 + qi;
            const int ai_ = seq >> 1;
            const int item = (seq & 1) ? 4160 + ai_ : (ai_ < 64 ? 4096 + ai_ : ai_ - 64);
#endif
            if (item < 4160) attn_item(p, item, qkvb, concat, wl, lane);
            else {
                const int j = item - 4160, tokblk = j >> 2, g = j & 3;
                LAS bf16_t* dt = (LAS bf16_t*)wl;
                if (g == 0) pool_item_g<0>(p, tokblk, ubuf, pwT, concat, dt, lane);
                else if (g == 1) pool_item_g<1>(p, tokblk, ubuf, pwT, concat, dt, lane);
                else if (g == 2) pool_item_g<2>(p, tokblk, ubuf, pwT, concat, dt, lane);
                else pool_item_g<3>(p, tokblk, ubuf, pwT, concat, dt, lane);
            }
        }
    }
    (void)ctr;
}

__global__ void __launch_bounds__(512, 2) fwd_megakernel(Params p) {
    __shared__ __attribute__((aligned(16))) unsigned char smem[pg8::STAGE_BYTES];
    LAS unsigned char* lds = (LAS unsigned char*)smem;
    cg::grid_group grid = cg::this_grid();
    __shared__ uint4 xb_words;
    if (threadIdx.x == 0) xb_words = make_uint4(0u, 0u, 0u, 0u);
    __syncthreads();
    const XcdBarrier gbar = xcd_barrier_post((unsigned*)(p.ws + WS_BAR), (volatile LAS unsigned*)&xb_words);
    const int tid = threadIdx.x, bid = blockIdx.x, nb = gridDim.x;
    bf16_t* xb = (bf16_t*)(p.ws + WS_A); bf16_t* hid = (bf16_t*)(p.ws + WS_A);
    bf16_t* qkvb = (bf16_t*)(p.ws + WS_B); bf16_t* pb16 = (bf16_t*)(p.ws + WS_B); bf16_t* ubuf = (bf16_t*)(p.ws + WS_UB);
    bf16_t* concat = (bf16_t*)(p.ws + WS_C);
    float* st1 = (float*)(p.ws + WS_ST1); float* st2 = (float*)(p.ws + WS_ST2);
#ifndef PHMASK
#define PHMASK 127
#endif
#ifndef REPMASK
#define REPMASK 0
#endif
#ifndef REPBAR
#define REPBAR 0
#endif
#define PH_RUN(k, lam) if ((PHMASK & (1 << (k))) && p.ph_lo <= (k) && (k) < p.ph_hi) { if ((k) > p.ph_lo) { if (p.ph_lo < 0) grid.sync(); else xcd_barrier(gbar); } \
        if ((REPMASK >> (k)) & 1) { lam(true); if (REPBAR) xcd_barrier(gbar); else __syncthreads(); } lam(false); }
    float* const dummy_st = (float*)(p.ws + WS_END);
    float* const scratch_y = (float*)(p.ws + WS_B + (size_t)MT * DM * 2);
    auto ph0 = [&](bool) { phase0(p, lds); };
    auto ph1 = [&](bool) {
        pg8::StaticOrder S; S.init(MP, NIN, nb, bid);
        EpiIn E{qkvb, ubuf, p.out};
        pg8::gemm_phase(lds, pg8::Gemm{xb, (const bf16_t*)(p.ws + WS_WIN), MP, NIN, DM}, S, E);
        mini_gemm_phase(lds, xb, (const bf16_t*)(p.ws + WS_WIN), DM, NIN / 64, 0, nb < 128 ? nb : 128, E);
    };
    auto ph2 = [&](bool) { phase2(p, lds, qkvb, ubuf, concat); };
    auto ph3 = [&](bool probe) {
        pg8::StaticOrder S; S.init(MP, DM, nb, bid);
        EpiOut E{xb, pb16, probe ? dummy_st : st1};
        pg8::gemm_phase(lds, pg8::Gemm{concat, (const bf16_t*)(p.ws + WS_WOUT), MP, DM, DM}, S, E);
        mini_gemm_phase(lds, concat, (const bf16_t*)(p.ws + WS_WOUT), DM, DM / 64, 0, nb < 64 ? nb : 64, E);
    };
    auto ph4 = [&](bool) {
        pg8::StaticOrder S; S.init(MP, NGU, nb, bid);
        EpiGU E{st1, (const float*)(p.ws + WS_CS), (const float*)(p.ws + WS_BW), hid};
        pg8::gemm_phase(lds, pg8::Gemm{pb16, (const bf16_t*)(p.ws + WS_WGU), MP, NGU, DM}, S, E);
        mini_gemm_phase(lds, pb16, (const bf16_t*)(p.ws + WS_WGU), DM, DFF / 32, nb == 256 ? 128 : 0, nb == 256 ? 128 : nb, E);
    };
    const bool fuse_ln2 = (nb == MP / 256 * (DM / 256)) && !((REPMASK >> 5) & 1);
    auto ph5f = [&](bool) {
        pg8::StaticOrder S; S.init(MP, DM, nb, bid);
        EpiDownF E{pb16, st1, p.ln1g, p.ln1b, st2, p.out + OFF_YP, p.ln2g, p.ln2b, (unsigned*)(p.ws + WS_BAR + 16384)};
        pg8::gemm_phase(lds, pg8::Gemm{hid, (const bf16_t*)(p.ws + WS_WD), MP, DM, DFF}, S, E);
        mini_gemm_phase(lds, hid, (const bf16_t*)(p.ws + WS_WD), DFF, DM / 64, 0, 64, E);
    };
    auto ph5 = [&](bool probe) {
        if (fuse_ln2) { ph5f(probe); return; }
        pg8::StaticOrder S; S.init(MP, DM, nb, bid);
        EpiDown E{pb16, st1, p.ln1g, p.ln1b, probe ? dummy_st : st2, probe ? scratch_y : p.out + OFF_YP};
        pg8::gemm_phase(lds, pg8::Gemm{hid, (const bf16_t*)(p.ws + WS_WD), MP, DM, DFF}, S, E);
        mini_gemm_phase(lds, hid, (const bf16_t*)(p.ws + WS_WD), DFF, DM / 64, 0, nb < 64 ? nb : 64, E);
    };
    auto ph6 = [&](bool probe) {
        f32x4* y4 = (f32x4*)(p.out + OFF_YP);
        f32x4* yo4 = probe ? (f32x4*)scratch_y : y4;
        const size_t n4 = (size_t)MT * DM / 4;
        for (size_t i = (size_t)bid * 512 + tid; i < n4; i += (size_t)nb * 512) {
            const int r = (int)(i >> 8), c4 = (int)(i & 255);
            const float s = st2[2 * r], q = st2[2 * r + 1];
            const float mu = s * (1.0f / DM); const float var = q * (1.0f / DM) - mu * mu; const float rstd = rsqrtf(var + LN_EPS);
            const f32x4 v = y4[i], gv = ((const f32x4*)p.ln2g)[c4], bv = ((const f32x4*)p.ln2b)[c4];
            yo4[i] = (v - mu) * rstd * gv + bv;
        }
    };
    PH_RUN(0, ph0) PH_RUN(1, ph1) PH_RUN(2, ph2) PH_RUN(3, ph3) PH_RUN(4, ph4) PH_RUN(5, ph5) if (!fuse_ln2) { PH_RUN(6, ph6) }
}

extern "C" void kernel_launch(void* const* d_in, const int* in_sizes, int n_in, void* d_out, int out_size, void* d_ws, size_t ws_size, hipStream_t stream) {
    static int grid_blocks = 0;
    if (!grid_blocks) {
        int dev = 0, cus = 0, per_cu = 0;
        hipGetDevice(&dev);
        hipDeviceGetAttribute(&cus, hipDeviceAttributeMultiprocessorCount, dev);
        hipOccupancyMaxActiveBlocksPerMultiprocessor(&per_cu, fwd_megakernel, 512, 0);
        if (per_cu < 1) { fprintf(stderr, "occupancy query says %d blocks/CU\n", per_cu); per_cu = 1; }
        if (per_cu > 1) per_cu = 1;
        grid_blocks = cus * per_cu;
        if (ws_size < WS_END) fprintf(stderr, "workspace too small: %zu < %zu\n", ws_size, (size_t)WS_END);
    }
    Params p{};
    p.xp = (const float*)d_in[0]; p.xs = (const float*)d_in[1]; p.ck = (const float*)d_in[2]; p.cv = (const float*)d_in[3]; p.sp = (const float*)d_in[4];
    p.w_in = (const float*)d_in[5]; p.pool_w = (const float*)d_in[6]; p.pool_scale = (const float*)d_in[7]; p.w_out = (const float*)d_in[8];
    p.ln1g = (const float*)d_in[9]; p.ln1b = (const float*)d_in[10]; p.wg = (const float*)d_in[11]; p.wu = (const float*)d_in[12]; p.wd = (const float*)d_in[13];
    p.ln2g = (const float*)d_in[14]; p.ln2b = (const float*)d_in[15];
    p.out = (float*)d_out; p.ws = (unsigned char*)d_ws;
    (void)hipMemsetAsync((unsigned char*)d_ws + WS_BAR, 0, WS_BAR_BYTES, stream);
#if MULTI_LAUNCH
    for (int ph = 0; ph < 7; ++ph) { p.ph_lo = ph; p.ph_hi = ph + 1; hipLaunchKernelGGL(fwd_megakernel, dim3(grid_blocks), dim3(512), 0, stream, p); }
#else
    p.ph_lo = 0; p.ph_hi = 7;
    void* args[] = {&p};
    hipError_t e = hipLaunchCooperativeKernel((void*)fwd_megakernel, dim3(grid_blocks), dim3(512), args, 0, stream);
    if (e != hipSuccess) fprintf(stderr, "cooperative launch failed: %s (grid %d)\n", hipGetErrorString(e), grid_blocks);
#endif
}
```

```cpp
#include <hip/hip_runtime.h>
#include <hip/hip_cooperative_groups.h>
#include <cstdio>
namespace cg = cooperative_groups;

#ifndef MULTI_LAUNCH
#define MULTI_LAUNCH 0
#endif

#define LAS __attribute__((address_space(3)))
typedef unsigned short bf16_t;
typedef short bf16x8 __attribute__((ext_vector_type(8)));
typedef float f32x4 __attribute__((ext_vector_type(4)));
typedef unsigned u32x2 __attribute__((ext_vector_type(2)));
typedef unsigned u32x4 __attribute__((ext_vector_type(4)));

constexpr int MP = 16384, MS = 256, MT = MP + MS;
constexpr int DM = 1024, NIN = 2048, DFF = 2816, NGU = 2 * DFF;
constexpr int SEQ = 4096, DSEQ = 32, PAST = 2048;
constexpr float ALPHA = 1.189207115002721f;
constexpr float LN_EPS = 1e-5f;
constexpr float R_EXIT = 130.0f;

constexpr size_t OFF_YP = 0, OFF_YS = 16777216, OFF_KP = 17039360, OFF_VP = 25427968, OFF_PP = 33816576,
                 OFF_KS = 33847296, OFF_VS = 33978368, OFF_PS = 34109440;

constexpr size_t WS_WIN = 0;
constexpr size_t WS_WOUT = WS_WIN + (size_t)NIN * DM * 2;
constexpr size_t WS_WGU = WS_WOUT + (size_t)DM * DM * 2;
constexpr size_t WS_WD = WS_WGU + (size_t)NGU * DM * 2;
constexpr size_t WS_PWT = WS_WD + (size_t)DM * DFF * 2;
constexpr size_t WS_CS = WS_PWT + 4 * 128 * 128 * 2;
constexpr size_t WS_BW = WS_CS + (size_t)NGU * 4;
constexpr size_t WS_ST1 = WS_BW + (size_t)NGU * 4;
constexpr size_t WS_ST2 = WS_ST1 + (size_t)MT * 2 * 4;
constexpr size_t WS_BAR = WS_ST2 + (size_t)MT * 2 * 4;
constexpr size_t WS_BAR_BYTES = 36864;
constexpr size_t WS_A = 24117248;
constexpr size_t WS_B = WS_A + (size_t)MT * DFF * 2;
constexpr size_t WS_UB = WS_B + (size_t)MT * 1536 * 2;
constexpr size_t WS_C = WS_UB + (size_t)MT * 512 * 4;
constexpr size_t WS_END = WS_C + (size_t)MT * DM * 2;
static_assert(WS_BAR + WS_BAR_BYTES <= WS_A, "ws map");
static_assert(WS_END <= 268435456ull, "ws map");

struct Params {
    const float *xp, *xs, *ck, *cv, *sp, *w_in, *pool_w, *pool_scale, *w_out, *ln1g, *ln1b, *wg, *wu, *wd, *ln2g, *ln2b;
    float* out; unsigned char* ws; int ph_lo, ph_hi;
};

__device__ __forceinline__ unsigned pk_bf16(float lo, float hi) { unsigned r; asm("v_cvt_pk_bf16_f32 %0, %1, %2" : "=v"(r) : "v"(lo), "v"(hi)); return r; }
__device__ __forceinline__ bf16_t f2bf(float f) { unsigned u = __float_as_uint(f); u += 0x7FFFu + ((u >> 16) & 1u); return (bf16_t)(u >> 16); }
__device__ __forceinline__ float bf2f(bf16_t b) { return __uint_as_float(((unsigned)b) << 16); }
__device__ __forceinline__ f32x4 up4(u32x2 w) { f32x4 v; v[0] = __uint_as_float(w.x << 16); v[1] = __uint_as_float(w.x & 0xffff0000u); v[2] = __uint_as_float(w.y << 16); v[3] = __uint_as_float(w.y & 0xffff0000u); return v; }
__device__ __forceinline__ u32x2 pk4(f32x4 v) { u32x2 o; o.x = pk_bf16(v[0], v[1]); o.y = pk_bf16(v[2], v[3]); return o; }


#define XB_TMO      128
#define XB_XCNT(j)  (256  + 64 * (j))
#define XB_XSUB(j)  (1280 + 64 * (j))
#define XB_XGEN(j)  (2304 + 64 * (j))
#define XB_TOP      3328
#define XB_TOPGEN   3392
#define XCD_BAR_WORDS 3456
#define XB_SPIN_CAP (1u << 22)
__device__ __forceinline__ unsigned xb_ld(unsigned* p)              { return __hip_atomic_load(p, __ATOMIC_RELAXED, __HIP_MEMORY_SCOPE_AGENT); }
__device__ __forceinline__ unsigned xb_add(unsigned* p, unsigned v) { return __hip_atomic_fetch_add(p, v, __ATOMIC_RELAXED, __HIP_MEMORY_SCOPE_AGENT); }
__device__ __forceinline__ unsigned xb_xcc_id() { return (unsigned)__builtin_amdgcn_s_getreg((3 << 11) | 20) & 0xFu; }
#define XB_SPIN(cond, bar) do { unsigned _sp = 0; while (cond) { __builtin_amdgcn_s_sleep(1); \
    if ((++_sp & 255u) == 0u) { if (xb_ld(&(bar)[XB_TMO])) break; if (_sp > XB_SPIN_CAP) { atomicAdd(&(bar)[XB_TMO], 1u); break; } } } } while (0)
struct XcdBarrier { unsigned* bar; unsigned x; volatile LAS unsigned* st; };
__device__ __forceinline__ XcdBarrier xcd_barrier_post(unsigned* bar, volatile LAS unsigned* st) {
    XcdBarrier b; b.bar = bar; b.x = xb_xcc_id(); b.st = st;
    if (threadIdx.x == 0) (void)xb_add(&bar[XB_XCNT(b.x)], 1u);
    return b;
}
__device__ __forceinline__ void xcd_barrier_complete(unsigned* bar, unsigned x, unsigned& nloc, unsigned& nx) {
    const unsigned G = gridDim.x * gridDim.y * gridDim.z;
    unsigned sum, cnt, mine, sp = 0u;
    for (;;) {
        sum = 0u; cnt = 0u; mine = 0u;
#pragma unroll
        for (unsigned j = 0; j < 16; ++j) { const unsigned c = xb_ld(&bar[XB_XCNT(j)]); sum += c; cnt += (c > 0u) ? 1u : 0u; mine = (j == x) ? c : mine; }
        if (sum == G) break;
        __builtin_amdgcn_s_sleep(1);
        if ((++sp & 255u) == 0u) { if (xb_ld(&bar[XB_TMO])) break; if (sp > XB_SPIN_CAP) { atomicAdd(&bar[XB_TMO], 1u); break; } }
    }
    nloc = mine > 0u ? mine : 1u; nx = cnt > 0u ? cnt : 1u;
}
__device__ __forceinline__ void xcd_barrier(const XcdBarrier& b) {
    asm volatile("s_waitcnt vmcnt(0)" ::: "memory");
    __syncthreads();
    if (threadIdx.x == 0) {
        unsigned* bar = b.bar;
        __builtin_amdgcn_s_waitcnt(0);
        unsigned nloc = b.st[0], nx = b.st[1];
        if (nloc == 0u) { xcd_barrier_complete(bar, b.x, nloc, nx); b.st[0] = nloc; b.st[1] = nx; }
        const unsigned old = xb_add(&bar[XB_XSUB(b.x)], 1u);
        const unsigned gen = old / nloc;
        if (old + 1u == (gen + 1u) * nloc) {
            __builtin_amdgcn_fence(__ATOMIC_RELEASE, "agent");
            asm volatile("s_waitcnt vmcnt(0)" ::: "memory");
            const unsigned og = xb_add(&bar[XB_TOP], 1u);
            const unsigned tg = og / nx;
            if (og + 1u == (tg + 1u) * nx) xb_add(&bar[XB_TOPGEN], 1u);
            else XB_SPIN(xb_ld(&bar[XB_TOPGEN]) == tg, bar);
            __builtin_amdgcn_fence(__ATOMIC_ACQUIRE, "agent");
            xb_add(&bar[XB_XGEN(b.x)], 1u);
            asm volatile("s_waitcnt vmcnt(0)" ::: "memory");
        } else {
            XB_SPIN(xb_ld(&bar[XB_XGEN(b.x)]) == gen, bar);
            __builtin_amdgcn_fence(__ATOMIC_ACQUIRE, "agent");
            asm volatile("s_waitcnt vmcnt(0)" ::: "memory");
        }
    }
    __syncthreads();
}

namespace pg8 {
constexpr int BM = 256, BK = 64, HALF = 128, HTB = HALF * BK * 2, STAGE_BYTES = 8 * HTB, NXCD = 8, WGM = 8;
__device__ __forceinline__ int lds_byte(int r, int c) { const int st = (r >> 4) * 2 + (c >> 5), rr = r & 15, cc = c & 31, ob = rr * 64 + cc * 2; return st * 1024 + (ob ^ (((ob >> 9) & 1) << 5)); }
__device__ __forceinline__ void stage_rc(int b, int& R, int& C) { const int st = b / 1024, sb = b % 1024, swz = sb ^ (((sb >> 9) & 1) << 5); R = (st >> 1) * 16 + swz / 64; C = (st & 1) * 32 + (swz % 64) / 2; }
struct Unit { int pm, pn; };
struct Gemm { const bf16_t* A; const bf16_t* Bt; int M, N, K; };
struct StaticOrder {
    int nM, nN, nwg, G, c;
    __device__ void init(int M, int N, int G_, int c_) { nM = M / BM; nN = N / BM; nwg = nM * nN; G = G_; c = c_; }
    __device__ bool next(int i, Unit& u) const {
        const long L = (long)i * G + c; if (L >= nwg) return false;
        int wgid = (int)L; { const int q = nwg / NXCD, r = nwg % NXCD, xcd = wgid % NXCD, off = wgid / NXCD; wgid = (xcd < r ? xcd * (q + 1) : r * (q + 1) + (xcd - r) * q) + off; }
        const int nig = WGM * nN, gid = wgid / nig, fm = gid * WGM, gsz = (nM - fm) < WGM ? (nM - fm) : WGM;
        u.pm = fm + ((wgid % nig) % gsz); u.pn = (wgid % nig) / gsz; return true;
    }
};

template <class Epi>
__device__ __forceinline__ void gemm_phase(LAS unsigned char* lds, const Gemm g, const StaticOrder& S, const Epi& E) {
    const int tid = threadIdx.x, wid = __builtin_amdgcn_readfirstlane(tid >> 6), lane = tid & 63, wr = wid >> 2, wc = wid & 3, fr = lane & 15, fq = lane >> 4;
    int K_ = g.K; asm volatile("" : "+s"(K_));
    const int K = K_, nt = K / BK;
    unsigned voffA[2];
#pragma unroll
    for (int i = 0; i < 2; ++i) { int R, C; stage_rc(tid * 16 + i * 8192, R, C); voffA[i] = (unsigned)(R * K + C) * 2u; }
    const size_t kstep = (size_t)(BK * 2);
    const size_t hstep = (size_t)HALF * K * 2;
    const size_t tstep = 2 * hstep;
    const unsigned ldsw = (unsigned)wid * 1024u;
    const int aoff = lds_byte(wr * 64 + fr, fq * 8), boff = lds_byte(wc * 32 + fr, fq * 8);
#define PG8_SA(b, h) (((b) * 2 + (h)) * HTB)
#define PG8_SB(b, h) ((4 + (b) * 2 + (h)) * HTB)
#define PG8_STAGE(bufoff, gbase, voff) do { _Pragma("unroll") for (int _i = 0; _i < 2; ++_i) \
        __builtin_amdgcn_global_load_lds((const unsigned*)((const char*)(gbase) + (voff)[_i]), (LAS unsigned*)(lds + (bufoff) + ldsw + _i * 8192), 16, 0, 0); } while (0)
#define PG8_LDA(dst, b, h) do { _Pragma("unroll") for (int m = 0; m < 4; ++m) _Pragma("unroll") for (int k = 0; k < 2; ++k) dst[m][k] = *(const LAS bf16x8*)(lds + PG8_SA(b, h) + aoff + m * 2048 + k * 1024); } while (0)
#define PG8_LDB(dst, b, h) do { _Pragma("unroll") for (int n = 0; n < 2; ++n) _Pragma("unroll") for (int k = 0; k < 2; ++k) dst[n][k] = *(const LAS bf16x8*)(lds + PG8_SB(b, h) + boff + n * 2048 + k * 1024); } while (0)
#define PG8_MMA(ai, bj, At, Bt) do { __builtin_amdgcn_s_setprio(1); _Pragma("unroll") for (int m = 0; m < 4; ++m) _Pragma("unroll") for (int n = 0; n < 2; ++n) _Pragma("unroll") for (int k = 0; k < 2; ++k) \
        acc[ai][bj][m][n] = __builtin_amdgcn_mfma_f32_16x16x32_bf16(Bt[n][k], At[m][k], acc[ai][bj][m][n], 0, 0, 0); __builtin_amdgcn_s_setprio(0); } while (0)
#define PG8_WAIT_V(n) asm volatile("s_waitcnt vmcnt(" #n ")" ::: "memory")
#define PG8_WAIT_L(n) asm volatile("s_waitcnt lgkmcnt(" #n ")" ::: "memory")
#define PG8_BAR __builtin_amdgcn_s_barrier()
#define PG8_SCHED __builtin_amdgcn_sched_barrier(0)
    Unit cur, nxt; int ui = 0;
    if (!S.next(0, cur)) return;
    f32x4 acc[2][2][4][2];
#pragma unroll
    for (int a = 0; a < 2; ++a)
#pragma unroll
        for (int b = 0; b < 2; ++b)
#pragma unroll
            for (int m = 0; m < 4; ++m)
#pragma unroll
                for (int n = 0; n < 2; ++n) acc[a][b][m][n] = (f32x4){0.f, 0.f, 0.f, 0.f};
    bf16x8 At[4][2], B0[2][2], B1[2][2];
    const char* cA = (const char*)g.A + (size_t)cur.pm * tstep; const char* cB = (const char*)g.Bt + (size_t)cur.pn * tstep;
    PG8_STAGE(PG8_SB(0, 0), cB, voffA); PG8_STAGE(PG8_SA(0, 0), cA, voffA); PG8_STAGE(PG8_SB(0, 1), cB + hstep, voffA); PG8_STAGE(PG8_SA(0, 1), cA + hstep, voffA);
    if (wr == 1) PG8_BAR;
    PG8_WAIT_V(4); PG8_BAR;
    PG8_STAGE(PG8_SB(1, 0), cB + kstep, voffA); PG8_STAGE(PG8_SA(1, 0), cA + kstep, voffA); PG8_STAGE(PG8_SB(1, 1), cB + hstep + kstep, voffA);
    PG8_WAIT_V(6); PG8_BAR;
    for (;;) {
        const bool has_next = S.next(ui + 1, nxt);
        const char* nA = has_next ? (const char*)g.A + (size_t)nxt.pm * tstep : cA; const char* nB = has_next ? (const char*)g.Bt + (size_t)nxt.pn * tstep : cB;
        for (int t = 0; t < nt; t += 2) {
            const bool last = (t == nt - 2);
            const char* a1 = cA + (size_t)(t + 1) * kstep;
            const char* a2 = last ? nA : cA + (size_t)(t + 2) * kstep; const char* b2 = last ? nB : cB + (size_t)(t + 2) * kstep;
            const char* a3 = a2 + kstep; const char* b3 = b2 + kstep;
            PG8_LDB(B0, 0, 0); PG8_SCHED; PG8_LDA(At, 0, 0); PG8_STAGE(PG8_SA(1, 1), a1 + hstep, voffA);
            PG8_WAIT_L(8); PG8_BAR; PG8_WAIT_L(0); PG8_MMA(0, 0, At, B0); PG8_BAR; PG8_SCHED;
            PG8_LDB(B1, 0, 1); PG8_STAGE(PG8_SB(0, 0), b2, voffA);
            PG8_BAR; PG8_WAIT_L(0); PG8_MMA(0, 1, At, B1); PG8_BAR;
            PG8_LDA(At, 0, 1); PG8_STAGE(PG8_SA(0, 0), a2, voffA);
            PG8_BAR; PG8_WAIT_L(0); PG8_MMA(1, 0, At, B0); PG8_BAR; PG8_SCHED;
            PG8_STAGE(PG8_SB(0, 1), b2 + hstep, voffA);
            PG8_WAIT_V(6); PG8_BAR; PG8_MMA(1, 1, At, B1); PG8_BAR;
            PG8_LDB(B0, 1, 0); PG8_SCHED; PG8_LDA(At, 1, 0); PG8_STAGE(PG8_SA(0, 1), a2 + hstep, voffA);
            PG8_WAIT_L(8); PG8_BAR; PG8_WAIT_L(0); PG8_MMA(0, 0, At, B0); PG8_BAR; PG8_SCHED;
            PG8_LDB(B1, 1, 1); PG8_STAGE(PG8_SB(1, 0), b3, voffA);
            PG8_BAR; PG8_WAIT_L(0); PG8_MMA(0, 1, At, B1); PG8_BAR;
            PG8_LDA(At, 1, 1); PG8_STAGE(PG8_SA(1, 0), a3, voffA);
            PG8_BAR; PG8_WAIT_L(0); PG8_MMA(1, 0, At, B0); PG8_BAR; PG8_SCHED;
            PG8_STAGE(PG8_SB(1, 1), b3 + hstep, voffA);
            PG8_WAIT_V(6); PG8_BAR; PG8_MMA(1, 1, At, B1); PG8_BAR;
        }
        if constexpr (Epi::AFTER_DRAIN) { if (has_next) epi_main(E, acc, cur, wr, wc, fr, fq); }
        else epi_main(E, acc, cur, wr, wc, fr, fq);
        if (!has_next) break;
#pragma unroll
        for (int a = 0; a < 2; ++a)
#pragma unroll
            for (int b = 0; b < 2; ++b)
#pragma unroll
                for (int m = 0; m < 4; ++m)
#pragma unroll
                    for (int n = 0; n < 2; ++n) acc[a][b][m][n] = (f32x4){0.f, 0.f, 0.f, 0.f};
        cur = nxt; cA = nA; cB = nB; ++ui;
    }
    PG8_WAIT_V(0);
    if (wr == 0) PG8_BAR;
    PG8_BAR;
    if constexpr (Epi::AFTER_DRAIN) E.fused(acc, cur, wr, wc, fr, fq);
#undef PG8_SA
#undef PG8_SB
#undef PG8_STAGE
#undef PG8_LDA
#undef PG8_LDB
#undef PG8_MMA
#undef PG8_WAIT_V
#undef PG8_WAIT_L
#undef PG8_BAR
#undef PG8_SCHED
}
}
using pg8::Unit;

__device__ __forceinline__ void ln_stats(const float* st, int r, float& mu, float& rstd) {
    const float s = st[2 * r], q = st[2 * r + 1];
    mu = s * (1.0f / DM); const float var = q * (1.0f / DM) - mu * mu; rstd = rsqrtf(var + LN_EPS);
}
struct EpiIn {
    static constexpr bool GU = false, STATS = false, AFTER_DRAIN = false;
    bf16_t* qkvb; bf16_t* ubuf; float* out;
    struct Row {};
    __device__ __forceinline__ Row row_begin(int) const { return Row{}; }
    __device__ __forceinline__ f32x4 load(const Row&, int, int) const { return (f32x4){0.f, 0.f, 0.f, 0.f}; }
    __device__ __forceinline__ void vec(const Row&, int r, int c, f32x4 v, f32x4, float&, float&) const {
        const int seg = c >> 9;
        if (seg == 0) {
            *(u32x2*)(qkvb + (size_t)r * 1536 + c) = pk4(v * (0.125f * 1.4426950408889634f));
        } else if (seg < 3) {
            *(u32x2*)(qkvb + (size_t)r * 1536 + c) = pk4(v);
            const int isv = seg == 2; const int cc = c & 511;
            float* dst = (r < MP) ? out + (isv ? OFF_VP : OFF_KP) + (size_t)r * 512 + cc
                                  : out + (isv ? OFF_VS : OFF_KS) + (size_t)(r - MP) * 512 + cc;
            __builtin_nontemporal_store(v, (f32x4*)dst);
        } else {
            const int cc = c & 511;
            *(u32x2*)(ubuf + (size_t)r * 512 + cc) = pk4(v);
            if (r < MP) { const int t = r & (SEQ - 1), b = r >> 12; if (t >= SEQ - 15) *(f32x4*)(out + OFF_PP + (size_t)(b * 15 + t - (SEQ - 15)) * 512 + cc) = v; }
            else { const int rr = r - MP, b = rr >> 5, t = rr & 31; if (t >= DSEQ - 15) *(f32x4*)(out + OFF_PS + (size_t)(b * 15 + t - (DSEQ - 15)) * 512 + cc) = v; }
        }
    }
    __device__ __forceinline__ void row_end(int, float, float) const {}
};
struct EpiOut {
    static constexpr bool GU = false, STATS = true, AFTER_DRAIN = false;
    const bf16_t* xb; bf16_t* pb16; float* st;
    struct Row {};
    __device__ __forceinline__ Row row_begin(int) const { return Row{}; }
    __device__ __forceinline__ f32x4 load(const Row&, int r, int c) const { return up4(*(const u32x2*)(xb + (size_t)r * DM + c)); }
    __device__ __forceinline__ void vec(const Row&, int r, int c, f32x4 v, f32x4 xv, float& s, float& q) const {
        const f32x4 pv = xv * ALPHA + v;
        *(u32x2*)(pb16 + (size_t)r * DM + c) = pk4(pv);
        s += (pv[0] + pv[1]) + (pv[2] + pv[3]);
        q += (pv[0] * pv[0] + pv[1] * pv[1]) + (pv[2] * pv[2] + pv[3] * pv[3]);
    }
    __device__ __forceinline__ void row_end(int r, float s, float q) const { atomicAdd(st + 2 * r, s); atomicAdd(st + 2 * r + 1, q); }
};
struct EpiGU {
    static constexpr bool GU = true, STATS = false, AFTER_DRAIN = false;
    const float* st; const float* cs; const float* bw; bf16_t* hid;
    struct Row { float mu, rstd; };
    __device__ __forceinline__ Row row_begin(int r) const { Row R; ln_stats(st, r, R.mu, R.rstd); return R; }
    __device__ __forceinline__ void vec2(const Row& R, int r, int ff, int cgi, f32x4 ga, f32x4 ua) const {
        const f32x4 csg = *(const f32x4*)(cs + cgi), csu = *(const f32x4*)(cs + cgi + 128);
        const f32x4 bwg = *(const f32x4*)(bw + cgi), bwu = *(const f32x4*)(bw + cgi + 128);
        vec2c(R, r, ff, ga, ua, csg, csu, bwg, bwu);
    }
    __device__ __forceinline__ void vec2c(const Row& R, int r, int ff, f32x4 ga, f32x4 ua, f32x4 csg, f32x4 csu, f32x4 bwg, f32x4 bwu) const {
        const f32x4 gt = (ga - csg * R.mu) * R.rstd + bwg;
        const f32x4 up = (ua - csu * R.mu) * R.rstd + bwu;
        f32x4 hv;
#pragma unroll
        for (int e = 0; e < 4; ++e) hv[e] = gt[e] * __builtin_amdgcn_rcpf(1.0f + __expf(-gt[e])) * up[e];
        *(u32x2*)(hid + (size_t)r * DFF + ff) = pk4(hv);
    }
};
struct EpiDown {
    static constexpr bool GU = false, STATS = true, AFTER_DRAIN = false;
    const bf16_t* pb16; const float* st1; const float* g1; const float* b1; float* st2; float* yo;
    struct Row { float mu, rstd; };
    __device__ __forceinline__ Row row_begin(int r) const { Row R; ln_stats(st1, r, R.mu, R.rstd); return R; }
    __device__ __forceinline__ f32x4 load(const Row&, int r, int c) const { return up4(*(const u32x2*)(pb16 + (size_t)r * DM + c)); }
    __device__ __forceinline__ void vec(const Row& R, int r, int c, f32x4 v, f32x4 pv, float& s, float& q) const {
        const f32x4 gv = *(const f32x4*)(g1 + c), bv = *(const f32x4*)(b1 + c);
        const f32x4 x1 = (pv - R.mu) * R.rstd * gv + bv;
        const f32x4 o = x1 * ALPHA + v;
        *(f32x4*)(yo + (size_t)r * DM + c) = o;
        s += (o[0] + o[1]) + (o[2] + o[3]);
        q += (o[0] * o[0] + o[1] * o[1]) + (o[2] * o[2] + o[3] * o[3]);
    }
    __device__ __forceinline__ void row_end(int r, float s, float q) const { atomicAdd(st2 + 2 * r, s); atomicAdd(st2 + 2 * r + 1, q); }
};

__device__ __forceinline__ void panel_meet(unsigned* cnt, unsigned want) {
    asm volatile("s_waitcnt vmcnt(0)" ::: "memory");
    __syncthreads();
    if (threadIdx.x == 0) {
        __builtin_amdgcn_fence(__ATOMIC_RELEASE, "agent");
        asm volatile("s_waitcnt vmcnt(0)" ::: "memory");
        __hip_atomic_fetch_add(cnt, 1u, __ATOMIC_RELAXED, __HIP_MEMORY_SCOPE_AGENT);
        unsigned sp = 0;
        while (__hip_atomic_load(cnt, __ATOMIC_RELAXED, __HIP_MEMORY_SCOPE_AGENT) < want) { __builtin_amdgcn_s_sleep(1); if (++sp > (1u << 24)) break; }
    }
    __syncthreads();
}
__device__ __forceinline__ void ln_stats_agent(float* st, int r, float& mu, float& rstd) {
    const float s = __hip_atomic_load(st + 2 * r, __ATOMIC_RELAXED, __HIP_MEMORY_SCOPE_AGENT), q = __hip_atomic_load(st + 2 * r + 1, __ATOMIC_RELAXED, __HIP_MEMORY_SCOPE_AGENT);
    mu = s * (1.0f / DM); const float var = q * (1.0f / DM) - mu * mu; rstd = rsqrtf(var + LN_EPS);
}
struct EpiDownF {
    static constexpr bool GU = false, STATS = true, AFTER_DRAIN = true;
    const bf16_t* pb16; const float* st1; const float* g1; const float* b1; float* st2; float* yo; const float* g2; const float* b2; unsigned* cnt;
    struct Row { float mu, rstd; };
    __device__ __forceinline__ Row row_begin(int r) const { Row R; ln_stats(st1, r, R.mu, R.rstd); return R; }
    __device__ __forceinline__ f32x4 load(const Row&, int r, int c) const { return up4(*(const u32x2*)(pb16 + (size_t)r * DM + c)); }
    __device__ __forceinline__ f32x4 pre2(const Row& R, int c, f32x4 v, f32x4 pv, float& s, float& q) const {
        const f32x4 gv = *(const f32x4*)(g1 + c), bv = *(const f32x4*)(b1 + c);
        const f32x4 x1 = (pv - R.mu) * R.rstd * gv + bv;
        const f32x4 o = x1 * ALPHA + v;
        s += (o[0] + o[1]) + (o[2] + o[3]);
        q += (o[0] * o[0] + o[1] * o[1]) + (o[2] * o[2] + o[3] * o[3]);
        return o;
    }
    __device__ __forceinline__ void vec(const Row& R, int r, int c, f32x4 v, f32x4 pv, float& s, float& q) const { *(f32x4*)(yo + (size_t)r * DM + c) = pre2(R, c, v, pv, s, q); }
    __device__ __forceinline__ void row_end(int r, float s, float q) const { atomicAdd(st2 + 2 * r, s); atomicAdd(st2 + 2 * r + 1, q); }
    __device__ __forceinline__ void fused(f32x4 (&acc)[2][2][4][2], const Unit& u, int wr, int wc, int fr, int fq) const {
        const int rbase = u.pm * 256 + wr * 64 + fr, cbase = u.pn * 256 + wc * 32 + 4 * fq;
        {
            Row Rn = row_begin(rbase);
            f32x4 inn[4];
#pragma unroll
            for (int j = 0; j < 4; ++j) inn[j] = load(Rn, rbase, cbase + (j >> 1) * 128 + (j & 1) * 16);
#pragma unroll
            for (int g = 0; g < 8; ++g) {
                const int ai = g >> 2, m = g & 3, r = rbase + ai * 128 + m * 16;
                const Row R = Rn;
                f32x4 in[4];
#pragma unroll
                for (int j = 0; j < 4; ++j) in[j] = inn[j];
                if (g < 7) {
                    const int r2 = rbase + ((g + 1) >> 2) * 128 + ((g + 1) & 3) * 16;
                    Rn = row_begin(r2);
#pragma unroll
                    for (int j = 0; j < 4; ++j) inn[j] = load(Rn, r2, cbase + (j >> 1) * 128 + (j & 1) * 16);
                }
                float s = 0.f, q = 0.f;
#pragma unroll
                for (int j = 0; j < 4; ++j) acc[ai][j >> 1][m][j & 1] = pre2(R, cbase + (j >> 1) * 128 + (j & 1) * 16, acc[ai][j >> 1][m][j & 1], in[j], s, q);
                s += __shfl_xor(s, 16); s += __shfl_xor(s, 32);
                q += __shfl_xor(q, 16); q += __shfl_xor(q, 32);
                if (fq == 0) row_end(r, s, q);
            }
        }
        panel_meet(cnt + 64 * u.pm, 4u);
        f32x4 gv[4], bv[4];
#pragma unroll
        for (int j = 0; j < 4; ++j) { const int c = cbase + (j >> 1) * 128 + (j & 1) * 16; gv[j] = *(const f32x4*)(g2 + c); bv[j] = *(const f32x4*)(b2 + c); }
        float mu8[8], rs8[8];
#pragma unroll
        for (int g = 0; g < 8; ++g) ln_stats_agent(st2, rbase + (g >> 2) * 128 + (g & 3) * 16, mu8[g], rs8[g]);
#pragma unroll
        for (int g = 0; g < 8; ++g) {
            const int ai = g >> 2, m = g & 3, r = rbase + ai * 128 + m * 16;
            const float mu = mu8[g], rstd = rs8[g];
#pragma unroll
            for (int j = 0; j < 4; ++j) __builtin_nontemporal_store((acc[ai][j >> 1][m][j & 1] - mu) * rstd * gv[j] + bv[j], (f32x4*)(yo + (size_t)r * DM + cbase + (j >> 1) * 128 + (j & 1) * 16));
        }
    }
    __device__ __forceinline__ void fused_mini(f32x4 (&acc)[2], int r, int rowblk, int c0, int fq) const {
        const Row R = row_begin(r);
        float s = 0.f, q = 0.f;
#pragma unroll
        for (int nb = 0; nb < 2; ++nb) acc[nb] = pre2(R, c0 + nb * 32, acc[nb], load(R, r, c0 + nb * 32), s, q);
        s += __shfl_xor(s, 16); s += __shfl_xor(s, 32);
        q += __shfl_xor(q, 16); q += __shfl_xor(q, 32);
        if (fq == 0) row_end(r, s, q);
        panel_meet(cnt + 64 * (64 + rowblk), 16u);
        float mu, rstd; ln_stats_agent(st2, r, mu, rstd);
#pragma unroll
        for (int nb = 0; nb < 2; ++nb) { const int c = c0 + nb * 32; *(f32x4*)(yo + (size_t)r * DM + c) = (acc[nb] - mu) * rstd * *(const f32x4*)(g2 + c) + *(const f32x4*)(b2 + c); }
    }
};

template <class Epi>
__device__ __forceinline__ void epi_main(const Epi& E, const f32x4 (&acc)[2][2][4][2], const Unit& u, int wr, int wc, int fr, int fq) {
    const int rbase = u.pm * 256 + wr * 64 + fr;
    if constexpr (Epi::GU) {
        f32x4 csg[2], csu[2], bwg[2], bwu[2];
#pragma unroll
        for (int n = 0; n < 2; ++n) {
            const int cgi = u.pn * 256 + wc * 32 + n * 16 + 4 * fq;
            csg[n] = *(const f32x4*)(E.cs + cgi); csu[n] = *(const f32x4*)(E.cs + cgi + 128);
            bwg[n] = *(const f32x4*)(E.bw + cgi); bwu[n] = *(const f32x4*)(E.bw + cgi + 128);
        }
        typename Epi::Row Rn = E.row_begin(rbase);
#pragma unroll
        for (int g = 0; g < 8; ++g) {
            const int ai = g >> 2, m = g & 3, r = rbase + ai * 128 + m * 16;
            const typename Epi::Row R = Rn;
            if (g < 7) Rn = E.row_begin(rbase + ((g + 1) >> 2) * 128 + ((g + 1) & 3) * 16);
#pragma unroll
            for (int n = 0; n < 2; ++n) E.vec2c(R, r, u.pn * 128 + wc * 32 + n * 16 + 4 * fq, acc[ai][0][m][n], acc[ai][1][m][n], csg[n], csu[n], bwg[n], bwu[n]);
        }
    } else {
        const int cbase = u.pn * 256 + wc * 32 + 4 * fq;
        typename Epi::Row Rn = E.row_begin(rbase);
        f32x4 inn[4];
#pragma unroll
        for (int j = 0; j < 4; ++j) inn[j] = E.load(Rn, rbase, cbase + (j >> 1) * 128 + (j & 1) * 16);
#pragma unroll
        for (int g = 0; g < 8; ++g) {
            const int ai = g >> 2, m = g & 3, r = rbase + ai * 128 + m * 16;
            const typename Epi::Row R = Rn;
            f32x4 in[4];
#pragma unroll
            for (int j = 0; j < 4; ++j) in[j] = inn[j];
            if (g < 7) {
                const int r2 = rbase + ((g + 1) >> 2) * 128 + ((g + 1) & 3) * 16;
                Rn = E.row_begin(r2);
#pragma unroll
                for (int j = 0; j < 4; ++j) inn[j] = E.load(Rn, r2, cbase + (j >> 1) * 128 + (j & 1) * 16);
            }
            float s = 0.f, q = 0.f;
#pragma unroll
            for (int j = 0; j < 4; ++j) E.vec(R, r, cbase + (j >> 1) * 128 + (j & 1) * 16, acc[ai][j >> 1][m][j & 1], in[j], s, q);
            if constexpr (Epi::STATS) {
                s += __shfl_xor(s, 16); s += __shfl_xor(s, 32);
                q += __shfl_xor(q, 16); q += __shfl_xor(q, 32);
                if (fq == 0) E.row_end(r, s, q);
            }
        }
    }
}

template <class Epi>
__device__ __forceinline__ void mini_gemm_tile(LAS unsigned char* lds, const bf16_t* __restrict__ A, const bf16_t* __restrict__ Bt, int K, int m0, int nt_idx, const Epi& E) {
    constexpr int LDT = 136;
    LAS bf16_t* As = (LAS bf16_t*)lds;
    LAS bf16_t* Bs = As + 2 * 64 * LDT;
    const int tid = threadIdx.x, lane = tid & 63, wave = tid >> 6, wr = wave >> 1, wc = wave & 1, fr = lane & 15, fq = lane >> 4;
    const int lrow = tid >> 3, lcol = (tid & 7) * 8;
    int brow;
    if constexpr (Epi::GU) brow = (nt_idx >> 2) * 256 + (lrow >> 5) * 128 + (nt_idx & 3) * 32 + (lrow & 31); else brow = nt_idx * 64 + lrow;
    const bf16_t* ap = A + (size_t)(m0 + lrow) * K + lcol;
    const bf16_t* bp = Bt + (size_t)brow * K + lcol;
    u32x4 ra[4], rb[4], rc[4], rd[4];
#define MG_LOAD(r, kt) do { r[0] = *(const u32x4*)(ap + (kt) * 128); r[1] = *(const u32x4*)(ap + (kt) * 128 + 64); r[2] = *(const u32x4*)(bp + (kt) * 128); r[3] = *(const u32x4*)(bp + (kt) * 128 + 64); } while (0)
#define MG_STORE(r, buf) do { *(LAS u32x4*)(As + ((buf) * 64 + lrow) * LDT + lcol) = r[0]; *(LAS u32x4*)(As + ((buf) * 64 + lrow) * LDT + lcol + 64) = r[1]; \
                              *(LAS u32x4*)(Bs + ((buf) * 64 + lrow) * LDT + lcol) = r[2]; *(LAS u32x4*)(Bs + ((buf) * 64 + lrow) * LDT + lcol + 64) = r[3]; } while (0)
#define MG_COMPUTE(buf) do { _Pragma("unroll") for (int ks = 0; ks < 4; ++ks) { \
        const bf16x8 af = *(const LAS bf16x8*)(As + ((buf) * 64 + wr * 16 + fr) * LDT + ks * 32 + fq * 8); \
        _Pragma("unroll") for (int nb = 0; nb < 2; ++nb) { const bf16x8 bfr = *(const LAS bf16x8*)(Bs + ((buf) * 64 + nb * 32 + wc * 16 + fr) * LDT + ks * 32 + fq * 8); \
            acc[nb] = __builtin_amdgcn_mfma_f32_16x16x32_bf16(bfr, af, acc[nb], 0, 0, 0); } } } while (0)
#define MG_STEP(r, kt_, buf) do { MG_STORE(r, buf); __syncthreads(); if ((kt_) + 4 < nkt) MG_LOAD(r, (kt_) + 4); MG_COMPUTE(buf); } while (0)
    f32x4 acc[2] = {(f32x4){0.f, 0.f, 0.f, 0.f}, (f32x4){0.f, 0.f, 0.f, 0.f}};
    const int nkt = K / 128;
    MG_LOAD(ra, 0); MG_LOAD(rb, 1); MG_LOAD(rc, 2); MG_LOAD(rd, 3);
    int kt = 0;
    for (; kt + 4 <= nkt; kt += 4) { MG_STEP(ra, kt, 0); MG_STEP(rb, kt + 1, 1); MG_STEP(rc, kt + 2, 0); MG_STEP(rd, kt + 3, 1); }
    if (kt < nkt) { MG_STEP(ra, kt, 0); MG_STEP(rb, kt + 1, 1); }
    __syncthreads();
#undef MG_STEP
#undef MG_LOAD
#undef MG_STORE
#undef MG_COMPUTE
    const int r = m0 + wr * 16 + fr;
    if constexpr (Epi::AFTER_DRAIN) { E.fused_mini(acc, r, (m0 - MP) >> 6, nt_idx * 64 + wc * 16 + 4 * fq, fq); return; }
    const typename Epi::Row R = E.row_begin(r);
    if constexpr (Epi::GU) {
        const int pn = nt_idx >> 2, ffo = (nt_idx & 3) * 32;
        E.vec2(R, r, pn * 128 + ffo + wc * 16 + 4 * fq, pn * 256 + ffo + wc * 16 + 4 * fq, acc[0], acc[1]);
    } else {
        float s = 0.f, q = 0.f;
#pragma unroll
        for (int nb = 0; nb < 2; ++nb) { const int c = nt_idx * 64 + nb * 32 + wc * 16 + 4 * fq; E.vec(R, r, c, acc[nb], E.load(R, r, c), s, q); }
        if constexpr (Epi::STATS) {
            s += __shfl_xor(s, 16); s += __shfl_xor(s, 32);
            q += __shfl_xor(q, 16); q += __shfl_xor(q, 32);
            if (fq == 0) E.row_end(r, s, q);
        }
    }
}
template <class Epi>
__device__ __forceinline__ void mini_gemm_phase(LAS unsigned char* lds, const bf16_t* A, const bf16_t* Bt, int K, int ntiles_n, int wg0, int nwg, const Epi& E) {
    const int me = (int)blockIdx.x - wg0;
    if (me < 0 || me >= nwg) return;
    for (int it = me; it < 4 * ntiles_n; it += nwg) mini_gemm_tile(lds, A, Bt, K, MP + (it & 3) * 64, it >> 2, E);
}

__device__ __forceinline__ void transpose_item(const float* __restrict__ src, int K, int N, int n0, bf16_t* __restrict__ dst, int ldd,
                                               const float* __restrict__ gs, const float* __restrict__ bv, float* cs_out, float* bw_out, LAS float* tile) {
    const int tid = threadIdx.x, ln = tid & 63, lr = tid >> 6;
    const int nt = K / 64;
    float cur[8], nxt[8];
#pragma unroll
    for (int i = 0; i < 8; ++i) cur[i] = src[(size_t)(lr + 8 * i) * N + n0 + ln];
    float csp = 0.f, bwp = 0.f;
    for (int t = 0; t < nt; ++t) {
        if (t + 1 < nt) {
#pragma unroll
            for (int i = 0; i < 8; ++i) nxt[i] = src[(size_t)((t + 1) * 64 + lr + 8 * i) * N + n0 + ln];
        }
        LAS float* tl = tile + (t & 1) * (64 * 65);
#pragma unroll
        for (int i = 0; i < 8; ++i) {
            const int k = t * 64 + lr + 8 * i;
            const float g = gs ? gs[k] : 1.0f; const float b = bv ? bv[k] : 0.0f;
            const float w = bf2f(f2bf(cur[i] * g));
            csp += w; bwp += b * cur[i];
            tl[(lr + 8 * i) * 65 + ln] = w;
        }
        __syncthreads();
#pragma unroll
        for (int i = 0; i < 8; ++i) {
            const int n = lr + 8 * i;
            dst[(size_t)n * ldd + t * 64 + ln] = f2bf(tl[ln * 65 + n]);
        }
#pragma unroll
        for (int i = 0; i < 8; ++i) cur[i] = nxt[i];
    }
    __syncthreads();
    if (cs_out) {
        LAS float* red = tile;
        red[lr * 64 + ln] = csp; red[512 + lr * 64 + ln] = bwp;
        __syncthreads();
        if (tid < 64) {
            float a = 0.f, b = 0.f;
#pragma unroll
            for (int i = 0; i < 8; ++i) { a += red[i * 64 + tid]; b += red[512 + i * 64 + tid]; }
            cs_out[tid] = a; bw_out[tid] = b;
        }
        __syncthreads();
    }
}

__device__ void phase0(const Params& p, LAS unsigned char* lds) {
    const int tid = threadIdx.x, nb = gridDim.x, bid = blockIdx.x;
    LAS float* tile = (LAS float*)lds;
    bf16_t* WinT = (bf16_t*)(p.ws + WS_WIN); bf16_t* WoutT = (bf16_t*)(p.ws + WS_WOUT); bf16_t* WguT = (bf16_t*)(p.ws + WS_WGU); bf16_t* WdT = (bf16_t*)(p.ws + WS_WD);
    bf16_t* pwT = (bf16_t*)(p.ws + WS_PWT); float* cs = (float*)(p.ws + WS_CS); float* bw = (float*)(p.ws + WS_BW);
    for (int item = bid; item < 160; item += nb) {
        if (item < 32) { const int n0 = item * 64; transpose_item(p.w_in, DM, NIN, n0, WinT + (size_t)n0 * DM, DM, nullptr, nullptr, nullptr, nullptr, tile); }
        else if (item < 48) { const int n0 = (item - 32) * 64; transpose_item(p.w_out, DM, DM, n0, WoutT + (size_t)n0 * DM, DM, nullptr, nullptr, nullptr, nullptr, tile); }
        else if (item < 136) {
            const int isu = item >= 92; const int n0 = (item - (isu ? 92 : 48)) * 64;
            const int drow = (n0 >> 7) * 256 + isu * 128 + (n0 & 127);
            transpose_item(isu ? p.wu : p.wg, DM, DFF, n0, WguT + (size_t)drow * DM, DM, p.ln1g, p.ln1b, cs + drow, bw + drow, tile);
        }
        else if (item < 152) { const int n0 = (item - 136) * 64; transpose_item(p.wd, DFF, DM, n0, WdT + (size_t)n0 * DFF, DFF, nullptr, nullptr, nullptr, nullptr, tile); }
        else { const int j = item - 152, g = j >> 1, n0 = (j & 1) * 64; transpose_item(p.pool_w + (size_t)g * 16384, 128, 128, n0, pwT + (size_t)g * 16384 + (size_t)n0 * 128, 128, nullptr, nullptr, nullptr, nullptr, tile); }
    }
    {
        bf16_t* xb = (bf16_t*)(p.ws + WS_A);
        const size_t n8 = (size_t)MT * DM / 8, np8 = (size_t)MP * DM / 8;
        for (size_t i = (size_t)bid * 512 + tid; i < n8; i += (size_t)nb * 512) {
            const f32x4* s = (i < np8) ? (const f32x4*)p.xp + 2 * i : (const f32x4*)p.xs + 2 * (i - np8);
            const f32x4 a = __builtin_nontemporal_load(s), b = __builtin_nontemporal_load(s + 1);
            u32x4 o; o.x = pk_bf16(a[0], a[1]); o.y = pk_bf16(a[2], a[3]); o.z = pk_bf16(b[0], b[1]); o.w = pk_bf16(b[2], b[3]);
            ((u32x4*)xb)[i] = o;
        }
    }
    {
        float* st = (float*)(p.ws + WS_ST1);
        for (int i = bid * 512 + tid; i < MT * 4; i += nb * 512) st[i] = 0.f;
    }
}

__device__ __forceinline__ float softplus2_f(float z2) { return fmaxf(z2, 0.f) + __builtin_amdgcn_logf(1.0f + __builtin_amdgcn_exp2f(-fabsf(z2))); }

__device__ __forceinline__ void attn_tile_t(const bf16x8 (&Kf)[2][2], const bf16x8 (&Qf)[2][2], LAS unsigned short* vt, f32x4 (&O)[2][4], float (&R)[2], bool DIAG, int c16, int g) {
    bf16x8 Vf[4];
#pragma unroll
    for (int db = 0; db < 4; ++db) {
        const u32x2 lo = *(const LAS u32x2*)(vt + (db * 16 + c16) * 36 + g * 4);
        const u32x2 hi = *(const LAS u32x2*)(vt + (db * 16 + c16) * 36 + 16 + g * 4);
        u32x4 o; o.x = lo.x; o.y = lo.y; o.z = hi.x; o.w = hi.y;
        Vf[db] = __builtin_bit_cast(bf16x8, o);
    }
#pragma unroll
    for (int qb = 0; qb < 2; ++qb) {
        f32x4 z[2];
#pragma unroll
        for (int kb = 0; kb < 2; ++kb) {
            z[kb] = __builtin_amdgcn_mfma_f32_16x16x32_bf16(Kf[kb][0], Qf[qb][0], (f32x4){0.f, 0.f, 0.f, 0.f}, 0, 0, 0);
            z[kb] = __builtin_amdgcn_mfma_f32_16x16x32_bf16(Kf[kb][1], Qf[qb][1], z[kb], 0, 0, 0);
        }
        float sp[2][4], lb[2][4]; bool ok[2][4];
        const int qrel = qb * 16 + c16;
#pragma unroll
        for (int kb = 0; kb < 2; ++kb)
#pragma unroll
            for (int j = 0; j < 4; ++j) {
                const int krel = kb * 16 + g * 4 + j;
                ok[kb][j] = (!DIAG) || (krel < qrel);
                const float zz = z[kb][j]; const float sf = softplus2_f(zz);
                sp[kb][j] = ok[kb][j] ? sf : 0.f; lb[kb][j] = zz - sf;
            }
        float ex[2][4], tot[2], hg[2], bt[2];
#pragma unroll
        for (int kb = 0; kb < 2; ++kb) {
            ex[kb][3] = 0.f; ex[kb][2] = sp[kb][3]; ex[kb][1] = ex[kb][2] + sp[kb][2]; ex[kb][0] = ex[kb][1] + sp[kb][1];
            tot[kb] = ex[kb][0] + sp[kb][0];
            const float a1 = __shfl_xor(tot[kb], 16), a2 = __shfl_xor(tot[kb], 32), a3 = __shfl_xor(tot[kb], 48);
            hg[kb] = (g == 0) ? (a1 + a2 + a3) : (g == 1) ? (a2 + a3) : (g == 2) ? a1 : 0.f;
            bt[kb] = (tot[kb] + a1) + (a2 + a3);
        }
        float pr[2][4];
#pragma unroll
        for (int j = 0; j < 4; ++j) {
            const float af1 = R[qb] + hg[1] + ex[1][j];
            const float af0 = R[qb] + bt[1] + hg[0] + ex[0][j];
            pr[1][j] = ok[1][j] ? __builtin_amdgcn_exp2f(lb[1][j] - af1) : 0.f;
            pr[0][j] = ok[0][j] ? __builtin_amdgcn_exp2f(lb[0][j] - af0) : 0.f;
        }
        R[qb] += bt[0] + bt[1];
        u32x4 po; po.x = pk_bf16(pr[0][0], pr[0][1]); po.y = pk_bf16(pr[0][2], pr[0][3]); po.z = pk_bf16(pr[1][0], pr[1][1]); po.w = pk_bf16(pr[1][2], pr[1][3]);
        const bf16x8 Pf = __builtin_bit_cast(bf16x8, po);
#pragma unroll
        for (int db = 0; db < 4; ++db) O[qb][db] = __builtin_amdgcn_mfma_f32_16x16x32_bf16(Vf[db], Pf, O[qb][db], 0, 0, 0);
    }
}
__device__ __forceinline__ void attn_tile(const bf16x8 (&Kf)[2][2], const bf16x8 (&Qf)[2][2], LAS unsigned short* vt, f32x4 (&O)[2][4], float (&R)[2], bool diag, int c16, int g) {
    attn_tile_t(Kf, Qf, vt, O, R, diag, c16, g);
}
#define WAVE_LDS_SYNC() do { asm volatile("" ::: "memory"); __builtin_amdgcn_wave_barrier(); asm volatile("" ::: "memory"); } while (0)

__device__ __forceinline__ void attn_item(const Params& p, int item, const bf16_t* __restrict__ qkvb, bf16_t* __restrict__ concat, LAS unsigned short* vt, int lane) {
    const bool prompt = item < 4096;
    int b, h, qt;
    if (prompt) { qt = item & 127; h = (item >> 7) & 7; b = item >> 10; } else { const int s = item - 4096; h = s & 7; b = s >> 3; qt = 0; }
    const size_t rowq = (prompt ? (size_t)b * SEQ : (size_t)MP + b * DSEQ) + qt * 32;
    const int qpos0 = (prompt ? 0 : PAST) + qt * 32;
    const int c16 = lane & 15, g = lane >> 4;
    bf16x8 Qf[2][2];
#pragma unroll
    for (int qb = 0; qb < 2; ++qb)
#pragma unroll
        for (int dh = 0; dh < 2; ++dh) Qf[qb][dh] = *(const bf16x8*)(qkvb + (rowq + qb * 16 + c16) * 1536 + h * 64 + dh * 32 + g * 8);
    f32x4 O[2][4];
#pragma unroll
    for (int qb = 0; qb < 2; ++qb)
#pragma unroll
        for (int db = 0; db < 4; ++db) O[qb][db] = (f32x4){0.f, 0.f, 0.f, 0.f};
    float R[2] = {0.f, 0.f};
    const int key = lane >> 1, dhalf = (lane & 1) * 32;
#ifndef ATTN_PREFETCH
#define ATTN_PREFETCH 0
#endif
    if (ATTN_PREFETCH && prompt) {
        const bf16_t* kbase = qkvb + ((size_t)b * SEQ + c16) * 1536 + 512 + h * 64 + g * 8;
        const bf16_t* vbase = qkvb + ((size_t)b * SEQ + key) * 1536 + 1024 + h * 64 + dhalf;
        bf16x8 Kr[2][2], Vr[4];
#define AT_LOAD(kp0) do { _Pragma("unroll") for (int kb = 0; kb < 2; ++kb) _Pragma("unroll") for (int dh = 0; dh < 2; ++dh) Kr[kb][dh] = *(const bf16x8*)(kbase + (size_t)((kp0) + kb * 16) * 1536 + dh * 32); \
                           _Pragma("unroll") for (int i = 0; i < 4; ++i) Vr[i] = *(const bf16x8*)(vbase + (size_t)(kp0) * 1536 + i * 8); } while (0)
        AT_LOAD(qpos0);
        for (int kt = qpos0 >> 5; kt >= 0; --kt) {
            bf16x8 Kf[2][2];
#pragma unroll
            for (int kb = 0; kb < 2; ++kb)
#pragma unroll
                for (int dh = 0; dh < 2; ++dh) Kf[kb][dh] = Kr[kb][dh];
#pragma unroll
            for (int i = 0; i < 4; ++i)
#pragma unroll
                for (int e = 0; e < 8; ++e) vt[(dhalf + i * 8 + e) * 36 + key] = (unsigned short)Vr[i][e];
            if (kt > 0) AT_LOAD((kt - 1) << 5);
            WAVE_LDS_SYNC();
            attn_tile(Kf, Qf, vt, O, R, (kt << 5) == qpos0, c16, g);
            WAVE_LDS_SYNC();
            if (__all(fminf(R[0], R[1]) > R_EXIT)) break;
        }
#undef AT_LOAD
    } else {
        for (int kt = qpos0 >> 5; kt >= 0; --kt) {
            const int kp0 = kt << 5;
            bf16x8 Kf[2][2];
            if (prompt || kp0 >= PAST) {
                const size_t krow = prompt ? (size_t)b * SEQ + kp0 : (size_t)MP + b * DSEQ + (kp0 - PAST);
#pragma unroll
                for (int kb = 0; kb < 2; ++kb)
#pragma unroll
                    for (int dh = 0; dh < 2; ++dh) Kf[kb][dh] = *(const bf16x8*)(qkvb + (krow + kb * 16 + c16) * 1536 + 512 + h * 64 + dh * 32 + g * 8);
                const bf16_t* vp = qkvb + (krow + key) * 1536 + 1024 + h * 64 + dhalf;
#pragma unroll
                for (int i = 0; i < 4; ++i) {
                    const bf16x8 v = *(const bf16x8*)(vp + i * 8);
#pragma unroll
                    for (int e = 0; e < 8; ++e) vt[(dhalf + i * 8 + e) * 36 + key] = (unsigned short)v[e];
                }
            } else {
                const float* kp = p.ck + ((size_t)(b * PAST + kp0) * 8 + h) * 64;
#pragma unroll
                for (int kb = 0; kb < 2; ++kb)
#pragma unroll
                    for (int dh = 0; dh < 2; ++dh) {
                        const float* sp_ = kp + (size_t)(kb * 16 + c16) * 512 + dh * 32 + g * 8;
                        const f32x4 a = *(const f32x4*)sp_, bb = *(const f32x4*)(sp_ + 4);
                        u32x4 o; o.x = pk_bf16(a[0], a[1]); o.y = pk_bf16(a[2], a[3]); o.z = pk_bf16(bb[0], bb[1]); o.w = pk_bf16(bb[2], bb[3]);
                        Kf[kb][dh] = __builtin_bit_cast(bf16x8, o);
                    }
                const float* vp = p.cv + ((size_t)(b * PAST + kp0 + key) * 8 + h) * 64 + dhalf;
#pragma unroll
                for (int i = 0; i < 8; ++i) {
                    const f32x4 v = *(const f32x4*)(vp + i * 4);
#pragma unroll
                    for (int e = 0; e < 4; ++e) vt[(dhalf + i * 4 + e) * 36 + key] = f2bf(v[e]);
                }
            }
            WAVE_LDS_SYNC();
            attn_tile(Kf, Qf, vt, O, R, kp0 == qpos0, c16, g);
            WAVE_LDS_SYNC();
            if (__all(fminf(R[0], R[1]) > R_EXIT)) break;
        }
    }
#pragma unroll
    for (int qb = 0; qb < 2; ++qb)
#pragma unroll
        for (int db = 0; db < 4; ++db)
            *(u32x2*)(concat + (rowq + qb * 16 + c16) * DM + h * 64 + db * 16 + g * 4) = pk4(O[qb][db]);
}

template <int G>
__device__ __forceinline__ void pool_item_g(const Params& p, int tokblk, const bf16_t* __restrict__ ubuf, const bf16_t* __restrict__ pwT, bf16_t* __restrict__ concat, LAS bf16_t* dt, int lane) {
    constexpr int W = 2 << G;
    const int r0 = tokblk * 16;
    int t0, start; size_t rb; const float* hist;
    if (r0 < MP) { t0 = r0 & (SEQ - 1); rb = (size_t)(r0 - t0); start = 0; hist = nullptr; }
    else { const int rr = r0 - MP; const int b = rr >> 5; t0 = rr & 31; rb = (size_t)MP + b * DSEQ; start = PAST; hist = p.sp + (size_t)b * 15 * 512; }
    const int c16 = lane & 15, gq = lane >> 4;
    const bf16_t* wbase = pwT + (size_t)G * 16384 + (size_t)c16 * 128 + gq * 8;
    float v[2][15 + W];
#pragma unroll
    for (int half = 0; half < 2; ++half) {
        const int ch = G * 128 + half * 64 + lane;
#pragma unroll
        for (int i = 0; i < 15 + W; ++i) {
            const int t = t0 - (W - 1) + i;
            const int tc = (t >= 0) ? t : 0;
            const float xu = bf2f(ubuf[(rb + tc) * 512 + ch]);
            const float xh = (t < 0 && hist) ? hist[(size_t)(15 + t) * 512 + ch] : 0.f;
            v[half][i] = (t >= 0) ? xu : xh;
        }
    }
#pragma unroll
    for (int half = 0; half < 2; ++half) {
        float s = 0.f;
#pragma unroll
        for (int i = 0; i < W - 1; ++i) s += v[half][i];
#pragma unroll
        for (int i = 0; i < 16; ++i) {
            const float cur = v[half][W - 1 + i];
            s += cur;
            const int cnt = min(W, start + t0 + i + 1);
            const float d = s / (float)cnt - cur;
            dt[i * 136 + half * 64 + lane] = f2bf(d);
            s -= v[half][i];
        }
    }
    WAVE_LDS_SYNC();
    f32x4 acc[8];
    bf16x8 bfrag[4];
#pragma unroll
    for (int ks = 0; ks < 4; ++ks) bfrag[ks] = *(const LAS bf16x8*)(dt + c16 * 136 + ks * 32 + gq * 8);
    const bf16_t* wp = wbase;
    asm volatile("" : "+v"(wp));
    bf16x8 wa[8][4];
#pragma unroll
    for (int nb = 0; nb < 8; ++nb)
#pragma unroll
        for (int ks = 0; ks < 4; ++ks) wa[nb][ks] = *(const bf16x8*)(wp + (size_t)nb * 16 * 128 + ks * 32);
    asm volatile("" ::: "memory");
#pragma unroll
    for (int nb = 0; nb < 8; ++nb) {
        acc[nb] = (f32x4){0.f, 0.f, 0.f, 0.f};
#pragma unroll
        for (int ks = 0; ks < 4; ++ks) acc[nb] = __builtin_amdgcn_mfma_f32_16x16x32_bf16(wa[nb][ks], bfrag[ks], acc[nb], 0, 0, 0);
    }
    const int row = r0 + c16;
#pragma unroll
    for (int nb = 0; nb < 8; ++nb) {
        const int dout = G * 128 + nb * 16 + gq * 4;
        const f32x4 sc = *(const f32x4*)(p.pool_scale + dout);
        *(u32x2*)(concat + (size_t)row * DM + 512 + dout) = pk4(acc[nb] * sc);
    }
    WAVE_LDS_SYNC();
}

constexpr int P2_ITEMS = 8320, P2_PER_Q = P2_ITEMS / 8;
__device__ __forceinline__ void phase2(const Params& p, LAS unsigned char* lds, const bf16_t* qkvb, const bf16_t* ubuf, bf16_t* concat) {
    const int tid = threadIdx.x, wave = tid >> 6, lane = tid & 63;
    LAS unsigned short* wl = (LAS unsigned short*)(lds + wave * 4608);
    unsigned* ctr = (unsigned*)(p.ws + WS_BAR + 14336);
    const bf16_t* pwT = (const bf16_t*)(p.ws + WS_PWT);
#ifndef P2_STATIC
#define P2_STATIC 0
#endif
#if P2_STATIC
    for (int item = (int)blockIdx.x * 8 + wave; item < P2_ITEMS; item += (int)gridDim.x * 8) {
        {
#else
    const int q0 = blockIdx.x & 7;
    for (int qq = 0; qq < 8; ++qq) {
        const int qi = (q0 + qq) & 7;
        for (;;) {
            unsigned i = 0;
            if (lane == 0) i = __hip_atomic_fetch_add(ctr + qi * 64, 1u, __ATOMIC_RELAXED, __HIP_MEMORY_SCOPE_AGENT);
            i = (unsigned)__builtin_amdgcn_readfirstlane((int)i);
            if (i >= (unsigned)P2_PER_Q) break;
            const int j = (int)i >> 1;
            const int item = ((int)i & 1) ? 4160 + qi * 520 + j : (j < 8 ? 4096 + qi * 8 + j : qi * 512 + (j - 8));
#endif
            if (item < 4160) attn_item(p, item, qkvb, concat, wl, lane);
            else {
                const int j = item - 4160, tokblk = j >> 2, g = j & 3;
                LAS bf16_t* dt = (LAS bf16_t*)wl;
                if (g == 0) pool_item_g<0>(p, tokblk, ubuf, pwT, concat, dt, lane);
                else if (g == 1) pool_item_g<1>(p, tokblk, ubuf, pwT, concat, dt, lane);
                else if (g == 2) pool_item_g<2>(p, tokblk, ubuf, pwT, concat, dt, lane);
                else pool_item_g<3>(p, tokblk, ubuf, pwT, concat, dt, lane);
            }
        }
    }
    (void)ctr;
}

__global__ void __launch_bounds__(512, 2) fwd_megakernel(Params p) {
    __shared__ __attribute__((aligned(16))) unsigned char smem[pg8::STAGE_BYTES];
    LAS unsigned char* lds = (LAS unsigned char*)smem;
    cg::grid_group grid = cg::this_grid();
    __shared__ uint4 xb_words;
    if (threadIdx.x == 0) xb_words = make_uint4(0u, 0u, 0u, 0u);
    __syncthreads();
    const XcdBarrier gbar = xcd_barrier_post((unsigned*)(p.ws + WS_BAR), (volatile LAS unsigned*)&xb_words);
    const int tid = threadIdx.x, bid = blockIdx.x, nb = gridDim.x;
    bf16_t* xb = (bf16_t*)(p.ws + WS_A); bf16_t* hid = (bf16_t*)(p.ws + WS_A);
    bf16_t* qkvb = (bf16_t*)(p.ws + WS_B); bf16_t* pb16 = (bf16_t*)(p.ws + WS_B); bf16_t* ubuf = (bf16_t*)(p.ws + WS_UB);
    bf16_t* concat = (bf16_t*)(p.ws + WS_C);
    float* st1 = (float*)(p.ws + WS_ST1); float* st2 = (float*)(p.ws + WS_ST2);
#ifndef PHMASK
#define PHMASK 127
#endif
#ifndef REPMASK
#define REPMASK 0
#endif
#ifndef REPBAR
#define REPBAR 0
#endif
#define PH_RUN(k, lam) if ((PHMASK & (1 << (k))) && p.ph_lo <= (k) && (k) < p.ph_hi) { if ((k) > p.ph_lo) { if (p.ph_lo < 0) grid.sync(); else xcd_barrier(gbar); } \
        if ((REPMASK >> (k)) & 1) { lam(true); if (REPBAR) xcd_barrier(gbar); else __syncthreads(); } lam(false); }
    float* const dummy_st = (float*)(p.ws + WS_END);
    float* const scratch_y = (float*)(p.ws + WS_B + (size_t)MT * DM * 2);
    auto ph0 = [&](bool) { phase0(p, lds); };
    auto ph1 = [&](bool) {
        pg8::StaticOrder S; S.init(MP, NIN, nb, bid);
        EpiIn E{qkvb, ubuf, p.out};
        pg8::gemm_phase(lds, pg8::Gemm{xb, (const bf16_t*)(p.ws + WS_WIN), MP, NIN, DM}, S, E);
        mini_gemm_phase(lds, xb, (const bf16_t*)(p.ws + WS_WIN), DM, NIN / 64, 0, nb < 128 ? nb : 128, E);
    };
    auto ph2 = [&](bool) { phase2(p, lds, qkvb, ubuf, concat); };
    auto ph3 = [&](bool probe) {
        pg8::StaticOrder S; S.init(MP, DM, nb, bid);
        EpiOut E{xb, pb16, probe ? dummy_st : st1};
        pg8::gemm_phase(lds, pg8::Gemm{concat, (const bf16_t*)(p.ws + WS_WOUT), MP, DM, DM}, S, E);
        mini_gemm_phase(lds, concat, (const bf16_t*)(p.ws + WS_WOUT), DM, DM / 64, 0, nb < 64 ? nb : 64, E);
    };
    auto ph4 = [&](bool) {
        pg8::StaticOrder S; S.init(MP, NGU, nb, bid);
        EpiGU E{st1, (const float*)(p.ws + WS_CS), (const float*)(p.ws + WS_BW), hid};
        pg8::gemm_phase(lds, pg8::Gemm{pb16, (const bf16_t*)(p.ws + WS_WGU), MP, NGU, DM}, S, E);
        mini_gemm_phase(lds, pb16, (const bf16_t*)(p.ws + WS_WGU), DM, DFF / 32, nb == 256 ? 128 : 0, nb == 256 ? 128 : nb, E);
    };
    const bool fuse_ln2 = (nb == MP / 256 * (DM / 256)) && !((REPMASK >> 5) & 1);
    auto ph5f = [&](bool) {
        pg8::StaticOrder S; S.init(MP, DM, nb, bid);
        EpiDownF E{pb16, st1, p.ln1g, p.ln1b, st2, p.out + OFF_YP, p.ln2g, p.ln2b, (unsigned*)(p.ws + WS_BAR + 16384)};
        pg8::gemm_phase(lds, pg8::Gemm{hid, (const bf16_t*)(p.ws + WS_WD), MP, DM, DFF}, S, E);
        mini_gemm_phase(lds, hid, (const bf16_t*)(p.ws + WS_WD), DFF, DM / 64, 0, 64, E);
    };
    auto ph5 = [&](bool probe) {
        if (fuse_ln2) { ph5f(probe); return; }
        pg8::StaticOrder S; S.init(MP, DM, nb, bid);
        EpiDown E{pb16, st1, p.ln1g, p.ln1b, probe ? dummy_st : st2, probe ? scratch_y : p.out + OFF_YP};
        pg8::gemm_phase(lds, pg8::Gemm{hid, (const bf16_t*)(p.ws + WS_WD), MP, DM, DFF}, S, E);
        mini_gemm_phase(lds, hid, (const bf16_t*)(p.ws + WS_WD), DFF, DM / 64, 0, nb < 64 ? nb : 64, E);
    };
    auto ph6 = [&](bool probe) {
        f32x4* y4 = (f32x4*)(p.out + OFF_YP);
        f32x4* yo4 = probe ? (f32x4*)scratch_y : y4;
        const size_t n4 = (size_t)MT * DM / 4;
        for (size_t i = (size_t)bid * 512 + tid; i < n4; i += (size_t)nb * 512) {
            const int r = (int)(i >> 8), c4 = (int)(i & 255);
            const float s = st2[2 * r], q = st2[2 * r + 1];
            const float mu = s * (1.0f / DM); const float var = q * (1.0f / DM) - mu * mu; const float rstd = rsqrtf(var + LN_EPS);
            const f32x4 v = y4[i], gv = ((const f32x4*)p.ln2g)[c4], bv = ((const f32x4*)p.ln2b)[c4];
            yo4[i] = (v - mu) * rstd * gv + bv;
        }
    };
    PH_RUN(0, ph0) PH_RUN(1, ph1) PH_RUN(2, ph2) PH_RUN(3, ph3) PH_RUN(4, ph4) PH_RUN(5, ph5) if (!fuse_ln2) { PH_RUN(6, ph6) }
}

extern "C" void kernel_launch(void* const* d_in, const int* in_sizes, int n_in, void* d_out, int out_size, void* d_ws, size_t ws_size, hipStream_t stream) {
    static int grid_blocks = 0;
    if (!grid_blocks) {
        int dev = 0, cus = 0, per_cu = 0;
        hipGetDevice(&dev);
        hipDeviceGetAttribute(&cus, hipDeviceAttributeMultiprocessorCount, dev);
        hipOccupancyMaxActiveBlocksPerMultiprocessor(&per_cu, fwd_megakernel, 512, 0);
        if (per_cu < 1) { fprintf(stderr, "occupancy query says %d blocks/CU\n", per_cu); per_cu = 1; }
        if (per_cu > 1) per_cu = 1;
        grid_blocks = cus * per_cu;
        if (ws_size < WS_END) fprintf(stderr, "workspace too small: %zu < %zu\n", ws_size, (size_t)WS_END);
    }
    Params p{};
    p.xp = (const float*)d_in[0]; p.xs = (const float*)d_in[1]; p.ck = (const float*)d_in[2]; p.cv = (const float*)d_in[3]; p.sp = (const float*)d_in[4];
    p.w_in = (const float*)d_in[5]; p.pool_w = (const float*)d_in[6]; p.pool_scale = (const float*)d_in[7]; p.w_out = (const float*)d_in[8];
    p.ln1g = (const float*)d_in[9]; p.ln1b = (const float*)d_in[10]; p.wg = (const float*)d_in[11]; p.wu = (const float*)d_in[12]; p.wd = (const float*)d_in[13];
    p.ln2g = (const float*)d_in[14]; p.ln2b = (const float*)d_in[15];
    p.out = (float*)d_out; p.ws = (unsigned char*)d_ws;
    (void)hipMemsetAsync((unsigned char*)d_ws + WS_BAR, 0, WS_BAR_BYTES, stream);
#if MULTI_LAUNCH
    for (int ph = 0; ph < 7; ++ph) { p.ph_lo = ph; p.ph_hi = ph + 1; hipLaunchKernelGGL(fwd_megakernel, dim3(grid_blocks), dim3(512), 0, stream, p); }
#else
    p.ph_lo = 0; p.ph_hi = 7;
    void* args[] = {&p};
    hipError_t e = hipLaunchCooperativeKernel((void*)fwd_megakernel, dim3(grid_blocks), dim3(512), args, 0, stream);
    if (e != hipSuccess) fprintf(stderr, "cooperative launch failed: %s (grid %d)\n", hipGetErrorString(e), grid_blocks);
#endif
}
```

```cpp
#include <hip/hip_runtime.h>
#include <hip/hip_cooperative_groups.h>
#include <cstdio>
namespace cg = cooperative_groups;

#ifndef MULTI_LAUNCH
#define MULTI_LAUNCH 0
#endif

#define LAS __attribute__((address_space(3)))
typedef unsigned short bf16_t;
typedef short bf16x8 __attribute__((ext_vector_type(8)));
typedef float f32x4 __attribute__((ext_vector_type(4)));
typedef unsigned u32x2 __attribute__((ext_vector_type(2)));
typedef unsigned u32x4 __attribute__((ext_vector_type(4)));

constexpr int MP = 16384, MS = 256, MT = MP + MS;
constexpr int DM = 1024, NIN = 2048, DFF = 2816, NGU = 2 * DFF;
constexpr int SEQ = 4096, DSEQ = 32, PAST = 2048;
constexpr float ALPHA = 1.189207115002721f;
constexpr float LN_EPS = 1e-5f;
constexpr float R_EXIT = 130.0f;

constexpr size_t OFF_YP = 0, OFF_YS = 16777216, OFF_KP = 17039360, OFF_VP = 25427968, OFF_PP = 33816576,
                 OFF_KS = 33847296, OFF_VS = 33978368, OFF_PS = 34109440;

constexpr size_t WS_WIN = 0;
constexpr size_t WS_WOUT = WS_WIN + (size_t)NIN * DM * 2;
constexpr size_t WS_WGU = WS_WOUT + (size_t)DM * DM * 2;
constexpr size_t WS_WD = WS_WGU + (size_t)NGU * DM * 2;
constexpr size_t WS_PWT = WS_WD + (size_t)DM * DFF * 2;
constexpr size_t WS_CS = WS_PWT + 4 * 128 * 128 * 2;
constexpr size_t WS_BW = WS_CS + (size_t)NGU * 4;
constexpr size_t WS_ST1 = WS_BW + (size_t)NGU * 4;
constexpr size_t WS_ST2 = WS_ST1 + (size_t)MT * 2 * 4;
constexpr size_t WS_BAR = WS_ST2 + (size_t)MT * 2 * 4;
constexpr size_t WS_BAR_BYTES = 36864;
constexpr size_t WS_A = 24117248;
constexpr size_t WS_B = WS_A + (size_t)MT * DFF * 2;
constexpr size_t WS_UB = WS_B + (size_t)MT * 1536 * 2;
constexpr size_t WS_C = WS_UB + (size_t)MT * 512 * 4;
constexpr size_t WS_END = WS_C + (size_t)MT * DM * 2;
static_assert(WS_BAR + WS_BAR_BYTES <= WS_A, "ws map");
static_assert(WS_END <= 268435456ull, "ws map");

struct Params {
    const float *xp, *xs, *ck, *cv, *sp, *w_in, *pool_w, *pool_scale, *w_out, *ln1g, *ln1b, *wg, *wu, *wd, *ln2g, *ln2b;
    float* out; unsigned char* ws; int ph_lo, ph_hi;
};

__device__ __forceinline__ unsigned pk_bf16(float lo, float hi) { unsigned r; asm("v_cvt_pk_bf16_f32 %0, %1, %2" : "=v"(r) : "v"(lo), "v"(hi)); return r; }
__device__ __forceinline__ bf16_t f2bf(float f) { unsigned u = __float_as_uint(f); u += 0x7FFFu + ((u >> 16) & 1u); return (bf16_t)(u >> 16); }
__device__ __forceinline__ float bf2f(bf16_t b) { return __uint_as_float(((unsigned)b) << 16); }
__device__ __forceinline__ f32x4 up4(u32x2 w) { f32x4 v; v[0] = __uint_as_float(w.x << 16); v[1] = __uint_as_float(w.x & 0xffff0000u); v[2] = __uint_as_float(w.y << 16); v[3] = __uint_as_float(w.y & 0xffff0000u); return v; }
__device__ __forceinline__ u32x2 pk4(f32x4 v) { u32x2 o; o.x = pk_bf16(v[0], v[1]); o.y = pk_bf16(v[2], v[3]); return o; }


#define XB_TMO      128
#define XB_XCNT(j)  (256  + 64 * (j))
#define XB_XSUB(j)  (1280 + 64 * (j))
#define XB_XGEN(j)  (2304 + 64 * (j))
#define XB_TOP      3328
#define XB_TOPGEN   3392
#define XCD_BAR_WORDS 3456
#define XB_SPIN_CAP (1u << 22)
__device__ __forceinline__ unsigned xb_ld(unsigned* p)              { return __hip_atomic_load(p, __ATOMIC_RELAXED, __HIP_MEMORY_SCOPE_AGENT); }
__device__ __forceinline__ unsigned xb_add(unsigned* p, unsigned v) { return __hip_atomic_fetch_add(p, v, __ATOMIC_RELAXED, __HIP_MEMORY_SCOPE_AGENT); }
__device__ __forceinline__ unsigned xb_xcc_id() { return (unsigned)__builtin_amdgcn_s_getreg((3 << 11) | 20) & 0xFu; }
#define XB_SPIN(cond, bar) do { unsigned _sp = 0; while (cond) { __builtin_amdgcn_s_sleep(1); \
    if ((++_sp & 255u) == 0u) { if (xb_ld(&(bar)[XB_TMO])) break; if (_sp > XB_SPIN_CAP) { atomicAdd(&(bar)[XB_TMO], 1u); break; } } } } while (0)
struct XcdBarrier { unsigned* bar; unsigned x; volatile LAS unsigned* st; };
__device__ __forceinline__ XcdBarrier xcd_barrier_post(unsigned* bar, volatile LAS unsigned* st) {
    XcdBarrier b; b.bar = bar; b.x = xb_xcc_id(); b.st = st;
    if (threadIdx.x == 0) (void)xb_add(&bar[XB_XCNT(b.x)], 1u);
    return b;
}
__device__ __forceinline__ void xcd_barrier_complete(unsigned* bar, unsigned x, unsigned& nloc, unsigned& nx) {
    const unsigned G = gridDim.x * gridDim.y * gridDim.z;
    unsigned sum, cnt, mine, sp = 0u;
    for (;;) {
        sum = 0u; cnt = 0u; mine = 0u;
#pragma unroll
        for (unsigned j = 0; j < 16; ++j) { const unsigned c = xb_ld(&bar[XB_XCNT(j)]); sum += c; cnt += (c > 0u) ? 1u : 0u; mine = (j == x) ? c : mine; }
        if (sum == G) break;
        __builtin_amdgcn_s_sleep(1);
        if ((++sp & 255u) == 0u) { if (xb_ld(&bar[XB_TMO])) break; if (sp > XB_SPIN_CAP) { atomicAdd(&bar[XB_TMO], 1u); break; } }
    }
    nloc = mine > 0u ? mine : 1u; nx = cnt > 0u ? cnt : 1u;
}
__device__ __forceinline__ void xcd_barrier(const XcdBarrier& b) {
    asm volatile("s_waitcnt vmcnt(0)" ::: "memory");
    __syncthreads();
    if (threadIdx.x == 0) {
        unsigned* bar = b.bar;
        __builtin_amdgcn_s_waitcnt(0);
        unsigned nloc = b.st[0], nx = b.st[1];
        if (nloc == 0u) { xcd_barrier_complete(bar, b.x, nloc, nx); b.st[0] = nloc; b.st[1] = nx; }
        const unsigned old = xb_add(&bar[XB_XSUB(b.x)], 1u);
        const unsigned gen = old / nloc;
        if (old + 1u == (gen + 1u) * nloc) {
            __builtin_amdgcn_fence(__ATOMIC_RELEASE, "agent");
            asm volatile("s_waitcnt vmcnt(0)" ::: "memory");
            const unsigned og = xb_add(&bar[XB_TOP], 1u);
            const unsigned tg = og / nx;
            if (og + 1u == (tg + 1u) * nx) xb_add(&bar[XB_TOPGEN], 1u);
            else XB_SPIN(xb_ld(&bar[XB_TOPGEN]) == tg, bar);
            __builtin_amdgcn_fence(__ATOMIC_ACQUIRE, "agent");
            xb_add(&bar[XB_XGEN(b.x)], 1u);
            asm volatile("s_waitcnt vmcnt(0)" ::: "memory");
        } else {
            XB_SPIN(xb_ld(&bar[XB_XGEN(b.x)]) == gen, bar);
            __builtin_amdgcn_fence(__ATOMIC_ACQUIRE, "agent");
            asm volatile("s_waitcnt vmcnt(0)" ::: "memory");
        }
    }
    __syncthreads();
}

namespace pg8 {
constexpr int BM = 256, BK = 64, HALF = 128, HTB = HALF * BK * 2, STAGE_BYTES = 8 * HTB, NXCD = 8, WGM = 8;
__device__ __forceinline__ int lds_byte(int r, int c) { const int st = (r >> 4) * 2 + (c >> 5), rr = r & 15, cc = c & 31, ob = rr * 64 + cc * 2; return st * 1024 + (ob ^ (((ob >> 9) & 1) << 5)); }
__device__ __forceinline__ void stage_rc(int b, int& R, int& C) { const int st = b / 1024, sb = b % 1024, swz = sb ^ (((sb >> 9) & 1) << 5); R = (st >> 1) * 16 + swz / 64; C = (st & 1) * 32 + (swz % 64) / 2; }
struct Unit { int pm, pn; };
struct Gemm { const bf16_t* A; const bf16_t* Bt; int M, N, K; };
struct StaticOrder {
    int nM, nN, nwg, G, c;
    __device__ void init(int M, int N, int G_, int c_) { nM = M / BM; nN = N / BM; nwg = nM * nN; G = G_; c = c_; }
    __device__ bool next(int i, Unit& u) const {
        const long L = (long)i * G + c; if (L >= nwg) return false;
        int wgid = (int)L; { const int q = nwg / NXCD, r = nwg % NXCD, xcd = wgid % NXCD, off = wgid / NXCD; wgid = (xcd < r ? xcd * (q + 1) : r * (q + 1) + (xcd - r) * q) + off; }
        const int nig = WGM * nN, gid = wgid / nig, fm = gid * WGM, gsz = (nM - fm) < WGM ? (nM - fm) : WGM;
        u.pm = fm + ((wgid % nig) % gsz); u.pn = (wgid % nig) / gsz; return true;
    }
};

template <class Epi>
__device__ __forceinline__ void gemm_phase(LAS unsigned char* lds, const Gemm g, const StaticOrder& S, const Epi& E) {
    const int tid = threadIdx.x, wid = __builtin_amdgcn_readfirstlane(tid >> 6), lane = tid & 63, wr = wid >> 2, wc = wid & 3, fr = lane & 15, fq = lane >> 4;
    int K_ = g.K; asm volatile("" : "+s"(K_));
    const int K = K_, nt = K / BK;
    unsigned voffA[2];
#pragma unroll
    for (int i = 0; i < 2; ++i) { int R, C; stage_rc(tid * 16 + i * 8192, R, C); voffA[i] = (unsigned)(R * K + C) * 2u; }
    const size_t kstep = (size_t)(BK * 2);
    const size_t hstep = (size_t)HALF * K * 2;
    const size_t tstep = 2 * hstep;
    const unsigned ldsw = (unsigned)wid * 1024u;
    const int aoff = lds_byte(wr * 64 + fr, fq * 8), boff = lds_byte(wc * 32 + fr, fq * 8);
#define PG8_SA(b, h) (((b) * 2 + (h)) * HTB)
#define PG8_SB(b, h) ((4 + (b) * 2 + (h)) * HTB)
#define PG8_STAGE(bufoff, gbase, voff) do { _Pragma("unroll") for (int _i = 0; _i < 2; ++_i) \
        __builtin_amdgcn_global_load_lds((const unsigned*)((const char*)(gbase) + (voff)[_i]), (LAS unsigned*)(lds + (bufoff) + ldsw + _i * 8192), 16, 0, 0); } while (0)
#define PG8_LDA(dst, b, h) do { _Pragma("unroll") for (int m = 0; m < 4; ++m) _Pragma("unroll") for (int k = 0; k < 2; ++k) dst[m][k] = *(const LAS bf16x8*)(lds + PG8_SA(b, h) + aoff + m * 2048 + k * 1024); } while (0)
#define PG8_LDB(dst, b, h) do { _Pragma("unroll") for (int n = 0; n < 2; ++n) _Pragma("unroll") for (int k = 0; k < 2; ++k) dst[n][k] = *(const LAS bf16x8*)(lds + PG8_SB(b, h) + boff + n * 2048 + k * 1024); } while (0)
#define PG8_MMA(ai, bj, At, Bt) do { __builtin_amdgcn_s_setprio(1); _Pragma("unroll") for (int m = 0; m < 4; ++m) _Pragma("unroll") for (int n = 0; n < 2; ++n) _Pragma("unroll") for (int k = 0; k < 2; ++k) \
        acc[ai][bj][m][n] = __builtin_amdgcn_mfma_f32_16x16x32_bf16(Bt[n][k], At[m][k], acc[ai][bj][m][n], 0, 0, 0); __builtin_amdgcn_s_setprio(0); } while (0)
#define PG8_WAIT_V(n) asm volatile("s_waitcnt vmcnt(" #n ")" ::: "memory")
#define PG8_WAIT_L(n) asm volatile("s_waitcnt lgkmcnt(" #n ")" ::: "memory")
#define PG8_BAR __builtin_amdgcn_s_barrier()
#define PG8_SCHED __builtin_amdgcn_sched_barrier(0)
    Unit cur, nxt; int ui = 0;
    if (!S.next(0, cur)) return;
    f32x4 acc[2][2][4][2];
#pragma unroll
    for (int a = 0; a < 2; ++a)
#pragma unroll
        for (int b = 0; b < 2; ++b)
#pragma unroll
            for (int m = 0; m < 4; ++m)
#pragma unroll
                for (int n = 0; n < 2; ++n) acc[a][b][m][n] = (f32x4){0.f, 0.f, 0.f, 0.f};
    bf16x8 At[4][2], B0[2][2], B1[2][2];
    const char* cA = (const char*)g.A + (size_t)cur.pm * tstep; const char* cB = (const char*)g.Bt + (size_t)cur.pn * tstep;
    PG8_STAGE(PG8_SB(0, 0), cB, voffA); PG8_STAGE(PG8_SA(0, 0), cA, voffA); PG8_STAGE(PG8_SB(0, 1), cB + hstep, voffA); PG8_STAGE(PG8_SA(0, 1), cA + hstep, voffA);
    if (wr == 1) PG8_BAR;
    PG8_WAIT_V(4); PG8_BAR;
    PG8_STAGE(PG8_SB(1, 0), cB + kstep, voffA); PG8_STAGE(PG8_SA(1, 0), cA + kstep, voffA); PG8_STAGE(PG8_SB(1, 1), cB + hstep + kstep, voffA);
    PG8_WAIT_V(6); PG8_BAR;
    for (;;) {
        const bool has_next = S.next(ui + 1, nxt);
        const char* nA = has_next ? (const char*)g.A + (size_t)nxt.pm * tstep : cA; const char* nB = has_next ? (const char*)g.Bt + (size_t)nxt.pn * tstep : cB;
        for (int t = 0; t < nt; t += 2) {
            const bool last = (t == nt - 2);
            const char* a1 = cA + (size_t)(t + 1) * kstep;
            const char* a2 = last ? nA : cA + (size_t)(t + 2) * kstep; const char* b2 = last ? nB : cB + (size_t)(t + 2) * kstep;
            const char* a3 = a2 + kstep; const char* b3 = b2 + kstep;
            PG8_LDB(B0, 0, 0); PG8_SCHED; PG8_LDA(At, 0, 0); PG8_STAGE(PG8_SA(1, 1), a1 + hstep, voffA);
            PG8_WAIT_L(8); PG8_BAR; PG8_WAIT_L(0); PG8_MMA(0, 0, At, B0); PG8_BAR; PG8_SCHED;
            PG8_LDB(B1, 0, 1); PG8_STAGE(PG8_SB(0, 0), b2, voffA);
            PG8_BAR; PG8_WAIT_L(0); PG8_MMA(0, 1, At, B1); PG8_BAR;
            PG8_LDA(At, 0, 1); PG8_STAGE(PG8_SA(0, 0), a2, voffA);
            PG8_BAR; PG8_WAIT_L(0); PG8_MMA(1, 0, At, B0); PG8_BAR; PG8_SCHED;
            PG8_STAGE(PG8_SB(0, 1), b2 + hstep, voffA);
            PG8_WAIT_V(6); PG8_BAR; PG8_MMA(1, 1, At, B1); PG8_BAR;
            PG8_LDB(B0, 1, 0); PG8_SCHED; PG8_LDA(At, 1, 0); PG8_STAGE(PG8_SA(0, 1), a2 + hstep, voffA);
            PG8_WAIT_L(8); PG8_BAR; PG8_WAIT_L(0); PG8_MMA(0, 0, At, B0); PG8_BAR; PG8_SCHED;
            PG8_LDB(B1, 1, 1); PG8_STAGE(PG8_SB(1, 0), b3, voffA);
            PG8_BAR; PG8_WAIT_L(0); PG8_MMA(0, 1, At, B1); PG8_BAR;
            PG8_LDA(At, 1, 1); PG8_STAGE(PG8_SA(1, 0), a3, voffA);
            PG8_BAR; PG8_WAIT_L(0); PG8_MMA(1, 0, At, B0); PG8_BAR; PG8_SCHED;
            PG8_STAGE(PG8_SB(1, 1), b3 + hstep, voffA);
            PG8_WAIT_V(6); PG8_BAR; PG8_MMA(1, 1, At, B1); PG8_BAR;
        }
        if constexpr (Epi::AFTER_DRAIN) { if (has_next) epi_main(E, acc, cur, wr, wc, fr, fq); }
        else epi_main(E, acc, cur, wr, wc, fr, fq);
        if (!has_next) break;
#pragma unroll
        for (int a = 0; a < 2; ++a)
#pragma unroll
            for (int b = 0; b < 2; ++b)
#pragma unroll
                for (int m = 0; m < 4; ++m)
#pragma unroll
                    for (int n = 0; n < 2; ++n) acc[a][b][m][n] = (f32x4){0.f, 0.f, 0.f, 0.f};
        cur = nxt; cA = nA; cB = nB; ++ui;
    }
    PG8_WAIT_V(0);
    if (wr == 0) PG8_BAR;
    PG8_BAR;
    if constexpr (Epi::AFTER_DRAIN) E.fused(acc, cur, wr, wc, fr, fq);
#undef PG8_SA
#undef PG8_SB
#undef PG8_STAGE
#undef PG8_LDA
#undef PG8_LDB
#undef PG8_MMA
#undef PG8_WAIT_V
#undef PG8_WAIT_L
#undef PG8_BAR
#undef PG8_SCHED
}
}
using pg8::Unit;

__device__ __forceinline__ void ln_stats(const float* st, int r, float& mu, float& rstd) {
    const float s = st[2 * r], q = st[2 * r + 1];
    mu = s * (1.0f / DM); const float var = q * (1.0f / DM) - mu * mu; rstd = rsqrtf(var + LN_EPS);
}
struct EpiIn {
    static constexpr bool GU = false, STATS = false, AFTER_DRAIN = false;
    bf16_t* qkvb; bf16_t* ubuf; float* out;
    struct Row {};
    __device__ __forceinline__ Row row_begin(int) const { return Row{}; }
    __device__ __forceinline__ f32x4 load(const Row&, int, int) const { return (f32x4){0.f, 0.f, 0.f, 0.f}; }
    __device__ __forceinline__ void vec(const Row&, int r, int c, f32x4 v, f32x4, float&, float&) const {
        const int seg = c >> 9;
        if (seg == 0) {
            *(u32x2*)(qkvb + (size_t)r * 1536 + c) = pk4(v * (0.125f * 1.4426950408889634f));
        } else if (seg < 3) {
            *(u32x2*)(qkvb + (size_t)r * 1536 + c) = pk4(v);
            const int isv = seg == 2; const int cc = c & 511;
            float* dst = (r < MP) ? out + (isv ? OFF_VP : OFF_KP) + (size_t)r * 512 + cc
                                  : out + (isv ? OFF_VS : OFF_KS) + (size_t)(r - MP) * 512 + cc;
            __builtin_nontemporal_store(v, (f32x4*)dst);
        } else {
            const int cc = c & 511;
            *(u32x2*)(ubuf + (size_t)r * 512 + cc) = pk4(v);
            if (r < MP) { const int t = r & (SEQ - 1), b = r >> 12; if (t >= SEQ - 15) *(f32x4*)(out + OFF_PP + (size_t)(b * 15 + t - (SEQ - 15)) * 512 + cc) = v; }
            else { const int rr = r - MP, b = rr >> 5, t = rr & 31; if (t >= DSEQ - 15) *(f32x4*)(out + OFF_PS + (size_t)(b * 15 + t - (DSEQ - 15)) * 512 + cc) = v; }
        }
    }
    __device__ __forceinline__ void row_end(int, float, float) const {}
};
struct EpiOut {
    static constexpr bool GU = false, STATS = true, AFTER_DRAIN = false;
    const bf16_t* xb; bf16_t* pb16; float* st;
    struct Row {};
    __device__ __forceinline__ Row row_begin(int) const { return Row{}; }
    __device__ __forceinline__ f32x4 load(const Row&, int r, int c) const { return up4(*(const u32x2*)(xb + (size_t)r * DM + c)); }
    __device__ __forceinline__ void vec(const Row&, int r, int c, f32x4 v, f32x4 xv, float& s, float& q) const {
        const f32x4 pv = xv * ALPHA + v;
        *(u32x2*)(pb16 + (size_t)r * DM + c) = pk4(pv);
        s += (pv[0] + pv[1]) + (pv[2] + pv[3]);
        q += (pv[0] * pv[0] + pv[1] * pv[1]) + (pv[2] * pv[2] + pv[3] * pv[3]);
    }
    __device__ __forceinline__ void row_end(int r, float s, float q) const { atomicAdd(st + 2 * r, s); atomicAdd(st + 2 * r + 1, q); }
};
struct EpiGU {
    static constexpr bool GU = true, STATS = false, AFTER_DRAIN = false;
    const float* st; const float* cs; const float* bw; bf16_t* hid;
    struct Row { float mu, rstd; };
    __device__ __forceinline__ Row row_begin(int r) const { Row R; ln_stats(st, r, R.mu, R.rstd); return R; }
    __device__ __forceinline__ void vec2(const Row& R, int r, int ff, int cgi, f32x4 ga, f32x4 ua) const {
        const f32x4 csg = *(const f32x4*)(cs + cgi), csu = *(const f32x4*)(cs + cgi + 128);
        const f32x4 bwg = *(const f32x4*)(bw + cgi), bwu = *(const f32x4*)(bw + cgi + 128);
        vec2c(R, r, ff, ga, ua, csg, csu, bwg, bwu);
    }
    __device__ __forceinline__ void vec2c(const Row& R, int r, int ff, f32x4 ga, f32x4 ua, f32x4 csg, f32x4 csu, f32x4 bwg, f32x4 bwu) const {
        const f32x4 gt = (ga - csg * R.mu) * R.rstd + bwg;
        const f32x4 up = (ua - csu * R.mu) * R.rstd + bwu;
        f32x4 hv;
#pragma unroll
        for (int e = 0; e < 4; ++e) hv[e] = gt[e] * __builtin_amdgcn_rcpf(1.0f + __expf(-gt[e])) * up[e];
        *(u32x2*)(hid + (size_t)r * DFF + ff) = pk4(hv);
    }
};
struct EpiDown {
    static constexpr bool GU = false, STATS = true, AFTER_DRAIN = false;
    const bf16_t* pb16; const float* st1; const float* g1; const float* b1; float* st2; float* yo;
    struct Row { float mu, rstd; };
    __device__ __forceinline__ Row row_begin(int r) const { Row R; ln_stats(st1, r, R.mu, R.rstd); return R; }
    __device__ __forceinline__ f32x4 load(const Row&, int r, int c) const { return up4(*(const u32x2*)(pb16 + (size_t)r * DM + c)); }
    __device__ __forceinline__ void vec(const Row& R, int r, int c, f32x4 v, f32x4 pv, float& s, float& q) const {
        const f32x4 gv = *(const f32x4*)(g1 + c), bv = *(const f32x4*)(b1 + c);
        const f32x4 x1 = (pv - R.mu) * R.rstd * gv + bv;
        const f32x4 o = x1 * ALPHA + v;
        *(f32x4*)(yo + (size_t)r * DM + c) = o;
        s += (o[0] + o[1]) + (o[2] + o[3]);
        q += (o[0] * o[0] + o[1] * o[1]) + (o[2] * o[2] + o[3] * o[3]);
    }
    __device__ __forceinline__ void row_end(int r, float s, float q) const { atomicAdd(st2 + 2 * r, s); atomicAdd(st2 + 2 * r + 1, q); }
};

__device__ __forceinline__ void panel_meet(unsigned* cnt, unsigned want) {
    asm volatile("s_waitcnt vmcnt(0)" ::: "memory");
    __syncthreads();
    if (threadIdx.x == 0) {
        __builtin_amdgcn_fence(__ATOMIC_RELEASE, "agent");
        asm volatile("s_waitcnt vmcnt(0)" ::: "memory");
        __hip_atomic_fetch_add(cnt, 1u, __ATOMIC_RELAXED, __HIP_MEMORY_SCOPE_AGENT);
        unsigned sp = 0;
        while (__hip_atomic_load(cnt, __ATOMIC_RELAXED, __HIP_MEMORY_SCOPE_AGENT) < want) { __builtin_amdgcn_s_sleep(1); if (++sp > (1u << 24)) break; }
    }
    __syncthreads();
}
__device__ __forceinline__ void ln_stats_agent(float* st, int r, float& mu, float& rstd) {
    const float s = __hip_atomic_load(st + 2 * r, __ATOMIC_RELAXED, __HIP_MEMORY_SCOPE_AGENT), q = __hip_atomic_load(st + 2 * r + 1, __ATOMIC_RELAXED, __HIP_MEMORY_SCOPE_AGENT);
    mu = s * (1.0f / DM); const float var = q * (1.0f / DM) - mu * mu; rstd = rsqrtf(var + LN_EPS);
}
struct EpiDownF {
    static constexpr bool GU = false, STATS = true, AFTER_DRAIN = true;
    const bf16_t* pb16; const float* st1; const float* g1; const float* b1; float* st2; float* yo; const float* g2; const float* b2; unsigned* cnt;
    struct Row { float mu, rstd; };
    __device__ __forceinline__ Row row_begin(int r) const { Row R; ln_stats(st1, r, R.mu, R.rstd); return R; }
    __device__ __forceinline__ f32x4 load(const Row&, int r, int c) const { return up4(*(const u32x2*)(pb16 + (size_t)r * DM + c)); }
    __device__ __forceinline__ f32x4 pre2(const Row& R, int c, f32x4 v, f32x4 pv, float& s, float& q) const {
        const f32x4 gv = *(const f32x4*)(g1 + c), bv = *(const f32x4*)(b1 + c);
        const f32x4 x1 = (pv - R.mu) * R.rstd * gv + bv;
        const f32x4 o = x1 * ALPHA + v;
        s += (o[0] + o[1]) + (o[2] + o[3]);
        q += (o[0] * o[0] + o[1] * o[1]) + (o[2] * o[2] + o[3] * o[3]);
        return o;
    }
    __device__ __forceinline__ void vec(const Row& R, int r, int c, f32x4 v, f32x4 pv, float& s, float& q) const { *(f32x4*)(yo + (size_t)r * DM + c) = pre2(R, c, v, pv, s, q); }
    __device__ __forceinline__ void row_end(int r, float s, float q) const { atomicAdd(st2 + 2 * r, s); atomicAdd(st2 + 2 * r + 1, q); }
    __device__ __forceinline__ void fused(f32x4 (&acc)[2][2][4][2], const Unit& u, int wr, int wc, int fr, int fq) const {
        const int rbase = u.pm * 256 + wr * 64 + fr, cbase = u.pn * 256 + wc * 32 + 4 * fq;
        {
            Row Rn = row_begin(rbase);
            f32x4 inn[4];
#pragma unroll
            for (int j = 0; j < 4; ++j) inn[j] = load(Rn, rbase, cbase + (j >> 1) * 128 + (j & 1) * 16);
#pragma unroll
            for (int g = 0; g < 8; ++g) {
                const int ai = g >> 2, m = g & 3, r = rbase + ai * 128 + m * 16;
                const Row R = Rn;
                f32x4 in[4];
#pragma unroll
                for (int j = 0; j < 4; ++j) in[j] = inn[j];
                if (g < 7) {
                    const int r2 = rbase + ((g + 1) >> 2) * 128 + ((g + 1) & 3) * 16;
                    Rn = row_begin(r2);
#pragma unroll
                    for (int j = 0; j < 4; ++j) inn[j] = load(Rn, r2, cbase + (j >> 1) * 128 + (j & 1) * 16);
                }
                float s = 0.f, q = 0.f;
#pragma unroll
                for (int j = 0; j < 4; ++j) acc[ai][j >> 1][m][j & 1] = pre2(R, cbase + (j >> 1) * 128 + (j & 1) * 16, acc[ai][j >> 1][m][j & 1], in[j], s, q);
                s += __shfl_xor(s, 16); s += __shfl_xor(s, 32);
                q += __shfl_xor(q, 16); q += __shfl_xor(q, 32);
                if (fq == 0) row_end(r, s, q);
            }
        }
        panel_meet(cnt + 64 * u.pm, 4u);
        f32x4 gv[4], bv[4];
#pragma unroll
        for (int j = 0; j < 4; ++j) { const int c = cbase + (j >> 1) * 128 + (j & 1) * 16; gv[j] = *(const f32x4*)(g2 + c); bv[j] = *(const f32x4*)(b2 + c); }
        float mu8[8], rs8[8];
#pragma unroll
        for (int g = 0; g < 8; ++g) ln_stats_agent(st2, rbase + (g >> 2) * 128 + (g & 3) * 16, mu8[g], rs8[g]);
#pragma unroll
        for (int g = 0; g < 8; ++g) {
            const int ai = g >> 2, m = g & 3, r = rbase + ai * 128 + m * 16;
            const float mu = mu8[g], rstd = rs8[g];
#pragma unroll
            for (int j = 0; j < 4; ++j) __builtin_nontemporal_store((acc[ai][j >> 1][m][j & 1] - mu) * rstd * gv[j] + bv[j], (f32x4*)(yo + (size_t)r * DM + cbase + (j >> 1) * 128 + (j & 1) * 16));
        }
    }
    __device__ __forceinline__ void fused_mini(f32x4 (&acc)[2], int r, int rowblk, int c0, int fq) const {
        const Row R = row_begin(r);
        float s = 0.f, q = 0.f;
#pragma unroll
        for (int nb = 0; nb < 2; ++nb) acc[nb] = pre2(R, c0 + nb * 32, acc[nb], load(R, r, c0 + nb * 32), s, q);
        s += __shfl_xor(s, 16); s += __shfl_xor(s, 32);
        q += __shfl_xor(q, 16); q += __shfl_xor(q, 32);
        if (fq == 0) row_end(r, s, q);
        panel_meet(cnt + 64 * (64 + rowblk), 16u);
        float mu, rstd; ln_stats_agent(st2, r, mu, rstd);
#pragma unroll
        for (int nb = 0; nb < 2; ++nb) { const int c = c0 + nb * 32; *(f32x4*)(yo + (size_t)r * DM + c) = (acc[nb] - mu) * rstd * *(const f32x4*)(g2 + c) + *(const f32x4*)(b2 + c); }
    }
};

template <class Epi>
__device__ __forceinline__ void epi_main(const Epi& E, const f32x4 (&acc)[2][2][4][2], const Unit& u, int wr, int wc, int fr, int fq) {
    const int rbase = u.pm * 256 + wr * 64 + fr;
    if constexpr (Epi::GU) {
        f32x4 csg[2], csu[2], bwg[2], bwu[2];
#pragma unroll
        for (int n = 0; n < 2; ++n) {
            const int cgi = u.pn * 256 + wc * 32 + n * 16 + 4 * fq;
            csg[n] = *(const f32x4*)(E.cs + cgi); csu[n] = *(const f32x4*)(E.cs + cgi + 128);
            bwg[n] = *(const f32x4*)(E.bw + cgi); bwu[n] = *(const f32x4*)(E.bw + cgi + 128);
        }
        typename Epi::Row Rn = E.row_begin(rbase);
#pragma unroll
        for (int g = 0; g < 8; ++g) {
            const int ai = g >> 2, m = g & 3, r = rbase + ai * 128 + m * 16;
            const typename Epi::Row R = Rn;
            if (g < 7) Rn = E.row_begin(rbase + ((g + 1) >> 2) * 128 + ((g + 1) & 3) * 16);
#pragma unroll
            for (int n = 0; n < 2; ++n) E.vec2c(R, r, u.pn * 128 + wc * 32 + n * 16 + 4 * fq, acc[ai][0][m][n], acc[ai][1][m][n], csg[n], csu[n], bwg[n], bwu[n]);
        }
    } else {
        const int cbase = u.pn * 256 + wc * 32 + 4 * fq;
        typename Epi::Row Rn = E.row_begin(rbase);
        f32x4 inn[4];
#pragma unroll
        for (int j = 0; j < 4; ++j) inn[j] = E.load(Rn, rbase, cbase + (j >> 1) * 128 + (j & 1) * 16);
#pragma unroll
        for (int g = 0; g < 8; ++g) {
            const int ai = g >> 2, m = g & 3, r = rbase + ai * 128 + m * 16;
            const typename Epi::Row R = Rn;
            f32x4 in[4];
#pragma unroll
            for (int j = 0; j < 4; ++j) in[j] = inn[j];
            if (g < 7) {
                const int r2 = rbase + ((g + 1) >> 2) * 128 + ((g + 1) & 3) * 16;
                Rn = E.row_begin(r2);
#pragma unroll
                for (int j = 0; j < 4; ++j) inn[j] = E.load(Rn, r2, cbase + (j >> 1) * 128 + (j & 1) * 16);
            }
            float s = 0.f, q = 0.f;
#pragma unroll
            for (int j = 0; j < 4; ++j) E.vec(R, r, cbase + (j >> 1) * 128 + (j & 1) * 16, acc[ai][j >> 1][m][j & 1], in[j], s, q);
            if constexpr (Epi::STATS) {
                s += __shfl_xor(s, 16); s += __shfl_xor(s, 32);
                q += __shfl_xor(q, 16); q += __shfl_xor(q, 32);
                if (fq == 0) E.row_end(r, s, q);
            }
        }
    }
}

template <class Epi>
__device__ __forceinline__ void mini_gemm_tile(LAS unsigned char* lds, const bf16_t* __restrict__ A, const bf16_t* __restrict__ Bt, int K, int m0, int nt_idx, const Epi& E) {
    constexpr int LDT = 136;
    LAS bf16_t* As = (LAS bf16_t*)lds;
    LAS bf16_t* Bs = As + 2 * 64 * LDT;
    const int tid = threadIdx.x, lane = tid & 63, wave = tid >> 6, wr = wave >> 1, wc = wave & 1, fr = lane & 15, fq = lane >> 4;
    const int lrow = tid >> 3, lcol = (tid & 7) * 8;
    int brow;
    if constexpr (Epi::GU) brow = (nt_idx >> 2) * 256 + (lrow >> 5) * 128 + (nt_idx & 3) * 32 + (lrow & 31); else brow = nt_idx * 64 + lrow;
    const bf16_t* ap = A + (size_t)(m0 + lrow) * K + lcol;
    const bf16_t* bp = Bt + (size_t)brow * K + lcol;
    u32x4 ra[4], rb[4], rc[4], rd[4];
#define MG_LOAD(r, kt) do { r[0] = *(const u32x4*)(ap + (kt) * 128); r[1] = *(const u32x4*)(ap + (kt) * 128 + 64); r[2] = *(const u32x4*)(bp + (kt) * 128); r[3] = *(const u32x4*)(bp + (kt) * 128 + 64); } while (0)
#define MG_STORE(r, buf) do { *(LAS u32x4*)(As + ((buf) * 64 + lrow) * LDT + lcol) = r[0]; *(LAS u32x4*)(As + ((buf) * 64 + lrow) * LDT + lcol + 64) = r[1]; \
                              *(LAS u32x4*)(Bs + ((buf) * 64 + lrow) * LDT + lcol) = r[2]; *(LAS u32x4*)(Bs + ((buf) * 64 + lrow) * LDT + lcol + 64) = r[3]; } while (0)
#define MG_COMPUTE(buf) do { _Pragma("unroll") for (int ks = 0; ks < 4; ++ks) { \
        const bf16x8 af = *(const LAS bf16x8*)(As + ((buf) * 64 + wr * 16 + fr) * LDT + ks * 32 + fq * 8); \
        _Pragma("unroll") for (int nb = 0; nb < 2; ++nb) { const bf16x8 bfr = *(const LAS bf16x8*)(Bs + ((buf) * 64 + nb * 32 + wc * 16 + fr) * LDT + ks * 32 + fq * 8); \
            acc[nb] = __builtin_amdgcn_mfma_f32_16x16x32_bf16(bfr, af, acc[nb], 0, 0, 0); } } } while (0)
#define MG_STEP(r, kt_, buf) do { MG_STORE(r, buf); __syncthreads(); if ((kt_) + 4 < nkt) MG_LOAD(r, (kt_) + 4); MG_COMPUTE(buf); } while (0)
    f32x4 acc[2] = {(f32x4){0.f, 0.f, 0.f, 0.f}, (f32x4){0.f, 0.f, 0.f, 0.f}};
    const int nkt = K / 128;
    MG_LOAD(ra, 0); MG_LOAD(rb, 1); MG_LOAD(rc, 2); MG_LOAD(rd, 3);
    int kt = 0;
    for (; kt + 4 <= nkt; kt += 4) { MG_STEP(ra, kt, 0); MG_STEP(rb, kt + 1, 1); MG_STEP(rc, kt + 2, 0); MG_STEP(rd, kt + 3, 1); }
    if (kt < nkt) { MG_STEP(ra, kt, 0); MG_STEP(rb, kt + 1, 1); }
    __syncthreads();
#undef MG_STEP
#undef MG_LOAD
#undef MG_STORE
#undef MG_COMPUTE
    const int r = m0 + wr * 16 + fr;
    if constexpr (Epi::AFTER_DRAIN) { E.fused_mini(acc, r, (m0 - MP) >> 6, nt_idx * 64 + wc * 16 + 4 * fq, fq); return; }
    const typename Epi::Row R = E.row_begin(r);
    if constexpr (Epi::GU) {
        const int pn = nt_idx >> 2, ffo = (nt_idx & 3) * 32;
        E.vec2(R, r, pn * 128 + ffo + wc * 16 + 4 * fq, pn * 256 + ffo + wc * 16 + 4 * fq, acc[0], acc[1]);
    } else {
        float s = 0.f, q = 0.f;
#pragma unroll
        for (int nb = 0; nb < 2; ++nb) { const int c = nt_idx * 64 + nb * 32 + wc * 16 + 4 * fq; E.vec(R, r, c, acc[nb], E.load(R, r, c), s, q); }
        if constexpr (Epi::STATS) {
            s += __shfl_xor(s, 16); s += __shfl_xor(s, 32);
            q += __shfl_xor(q, 16); q += __shfl_xor(q, 32);
            if (fq == 0) E.row_end(r, s, q);
        }
    }
}
template <class Epi>
__device__ __forceinline__ void mini_gemm_phase(LAS unsigned char* lds, const bf16_t* A, const bf16_t* Bt, int K, int ntiles_n, int wg0, int nwg, const Epi& E) {
    const int me = (int)blockIdx.x - wg0;
    if (me < 0 || me >= nwg) return;
    for (int it = me; it < 4 * ntiles_n; it += nwg) mini_gemm_tile(lds, A, Bt, K, MP + (it & 3) * 64, it >> 2, E);
}

__device__ __forceinline__ void transpose_item(const float* __restrict__ src, int K, int N, int n0, bf16_t* __restrict__ dst, int ldd,
                                               const float* __restrict__ gs, const float* __restrict__ bv, float* cs_out, float* bw_out, LAS float* tile) {
    const int tid = threadIdx.x, ln = tid & 63, lr = tid >> 6;
    const int nt = K / 64;
    float cur[8], nxt[8];
#pragma unroll
    for (int i = 0; i < 8; ++i) cur[i] = src[(size_t)(lr + 8 * i) * N + n0 + ln];
    float csp = 0.f, bwp = 0.f;
    for (int t = 0; t < nt; ++t) {
        if (t + 1 < nt) {
#pragma unroll
            for (int i = 0; i < 8; ++i) nxt[i] = src[(size_t)((t + 1) * 64 + lr + 8 * i) * N + n0 + ln];
        }
        LAS float* tl = tile + (t & 1) * (64 * 65);
#pragma unroll
        for (int i = 0; i < 8; ++i) {
            const int k = t * 64 + lr + 8 * i;
            const float g = gs ? gs[k] : 1.0f; const float b = bv ? bv[k] : 0.0f;
            const float w = bf2f(f2bf(cur[i] * g));
            csp += w; bwp += b * cur[i];
            tl[(lr + 8 * i) * 65 + ln] = w;
        }
        __syncthreads();
#pragma unroll
        for (int i = 0; i < 8; ++i) {
            const int n = lr + 8 * i;
            dst[(size_t)n * ldd + t * 64 + ln] = f2bf(tl[ln * 65 + n]);
        }
#pragma unroll
        for (int i = 0; i < 8; ++i) cur[i] = nxt[i];
    }
    __syncthreads();
    if (cs_out) {
        LAS float* red = tile;
        red[lr * 64 + ln] = csp; red[512 + lr * 64 + ln] = bwp;
        __syncthreads();
        if (tid < 64) {
            float a = 0.f, b = 0.f;
#pragma unroll
            for (int i = 0; i < 8; ++i) { a += red[i * 64 + tid]; b += red[512 + i * 64 + tid]; }
            cs_out[tid] = a; bw_out[tid] = b;
        }
        __syncthreads();
    }
}

__device__ void phase0(const Params& p, LAS unsigned char* lds) {
    const int tid = threadIdx.x, nb = gridDim.x, bid = blockIdx.x;
    LAS float* tile = (LAS float*)lds;
    bf16_t* WinT = (bf16_t*)(p.ws + WS_WIN); bf16_t* WoutT = (bf16_t*)(p.ws + WS_WOUT); bf16_t* WguT = (bf16_t*)(p.ws + WS_WGU); bf16_t* WdT = (bf16_t*)(p.ws + WS_WD);
    bf16_t* pwT = (bf16_t*)(p.ws + WS_PWT); float* cs = (float*)(p.ws + WS_CS); float* bw = (float*)(p.ws + WS_BW);
    for (int item = bid; item < 160; item += nb) {
        if (item < 32) { const int n0 = item * 64; transpose_item(p.w_in, DM, NIN, n0, WinT + (size_t)n0 * DM, DM, nullptr, nullptr, nullptr, nullptr, tile); }
        else if (item < 48) { const int n0 = (item - 32) * 64; transpose_item(p.w_out, DM, DM, n0, WoutT + (size_t)n0 * DM, DM, nullptr, nullptr, nullptr, nullptr, tile); }
        else if (item < 136) {
            const int isu = item >= 92; const int n0 = (item - (isu ? 92 : 48)) * 64;
            const int drow = (n0 >> 7) * 256 + isu * 128 + (n0 & 127);
            transpose_item(isu ? p.wu : p.wg, DM, DFF, n0, WguT + (size_t)drow * DM, DM, p.ln1g, p.ln1b, cs + drow, bw + drow, tile);
        }
        else if (item < 152) { const int n0 = (item - 136) * 64; transpose_item(p.wd, DFF, DM, n0, WdT + (size_t)n0 * DFF, DFF, nullptr, nullptr, nullptr, nullptr, tile); }
        else { const int j = item - 152, g = j >> 1, n0 = (j & 1) * 64; transpose_item(p.pool_w + (size_t)g * 16384, 128, 128, n0, pwT + (size_t)g * 16384 + (size_t)n0 * 128, 128, nullptr, nullptr, nullptr, nullptr, tile); }
    }
    {
        bf16_t* xb = (bf16_t*)(p.ws + WS_A);
        const size_t n8 = (size_t)MT * DM / 8, np8 = (size_t)MP * DM / 8;
        for (size_t i = (size_t)bid * 512 + tid; i < n8; i += (size_t)nb * 512) {
            const f32x4* s = (i < np8) ? (const f32x4*)p.xp + 2 * i : (const f32x4*)p.xs + 2 * (i - np8);
            const f32x4 a = __builtin_nontemporal_load(s), b = __builtin_nontemporal_load(s + 1);
            u32x4 o; o.x = pk_bf16(a[0], a[1]); o.y = pk_bf16(a[2], a[3]); o.z = pk_bf16(b[0], b[1]); o.w = pk_bf16(b[2], b[3]);
            ((u32x4*)xb)[i] = o;
        }
    }
    {
        float* st = (float*)(p.ws + WS_ST1);
        for (int i = bid * 512 + tid; i < MT * 4; i += nb * 512) st[i] = 0.f;
    }
}

__device__ __forceinline__ float softplus2_f(float z2) { return fmaxf(z2, 0.f) + __builtin_amdgcn_logf(1.0f + __builtin_amdgcn_exp2f(-fabsf(z2))); }

__device__ __forceinline__ void attn_tile_t(const bf16x8 (&Kf)[2][2], const bf16x8 (&Qf)[2][2], LAS unsigned short* vt, f32x4 (&O)[2][4], float (&R)[2], bool DIAG, int c16, int g) {
    bf16x8 Vf[4];
#pragma unroll
    for (int db = 0; db < 4; ++db) {
        const u32x2 lo = *(const LAS u32x2*)(vt + (db * 16 + c16) * 36 + g * 4);
        const u32x2 hi = *(const LAS u32x2*)(vt + (db * 16 + c16) * 36 + 16 + g * 4);
        u32x4 o; o.x = lo.x; o.y = lo.y; o.z = hi.x; o.w = hi.y;
        Vf[db] = __builtin_bit_cast(bf16x8, o);
    }
#pragma unroll
    for (int qb = 0; qb < 2; ++qb) {
        f32x4 z[2];
#pragma unroll
        for (int kb = 0; kb < 2; ++kb) {
            z[kb] = __builtin_amdgcn_mfma_f32_16x16x32_bf16(Kf[kb][0], Qf[qb][0], (f32x4){0.f, 0.f, 0.f, 0.f}, 0, 0, 0);
            z[kb] = __builtin_amdgcn_mfma_f32_16x16x32_bf16(Kf[kb][1], Qf[qb][1], z[kb], 0, 0, 0);
        }
        float sp[2][4], lb[2][4]; bool ok[2][4];
        const int qrel = qb * 16 + c16;
#pragma unroll
        for (int kb = 0; kb < 2; ++kb)
#pragma unroll
            for (int j = 0; j < 4; ++j) {
                const int krel = kb * 16 + g * 4 + j;
                ok[kb][j] = (!DIAG) || (krel < qrel);
                const float zz = z[kb][j]; const float sf = softplus2_f(zz);
                sp[kb][j] = ok[kb][j] ? sf : 0.f; lb[kb][j] = zz - sf;
            }
        float ex[2][4], tot[2], hg[2], bt[2];
#pragma unroll
        for (int kb = 0; kb < 2; ++kb) {
            ex[kb][3] = 0.f; ex[kb][2] = sp[kb][3]; ex[kb][1] = ex[kb][2] + sp[kb][2]; ex[kb][0] = ex[kb][1] + sp[kb][1];
            tot[kb] = ex[kb][0] + sp[kb][0];
            const float a1 = __shfl_xor(tot[kb], 16), a2 = __shfl_xor(tot[kb], 32), a3 = __shfl_xor(tot[kb], 48);
            hg[kb] = (g == 0) ? (a1 + a2 + a3) : (g == 1) ? (a2 + a3) : (g == 2) ? a1 : 0.f;
            bt[kb] = (tot[kb] + a1) + (a2 + a3);
        }
        float pr[2][4];
#pragma unroll
        for (int j = 0; j < 4; ++j) {
            const float af1 = R[qb] + hg[1] + ex[1][j];
            const float af0 = R[qb] + bt[1] + hg[0] + ex[0][j];
            pr[1][j] = ok[1][j] ? __builtin_amdgcn_exp2f(lb[1][j] - af1) : 0.f;
            pr[0][j] = ok[0][j] ? __builtin_amdgcn_exp2f(lb[0][j] - af0) : 0.f;
        }
        R[qb] += bt[0] + bt[1];
        u32x4 po; po.x = pk_bf16(pr[0][0], pr[0][1]); po.y = pk_bf16(pr[0][2], pr[0][3]); po.z = pk_bf16(pr[1][0], pr[1][1]); po.w = pk_bf16(pr[1][2], pr[1][3]);
        const bf16x8 Pf = __builtin_bit_cast(bf16x8, po);
#pragma unroll
        for (int db = 0; db < 4; ++db) O[qb][db] = __builtin_amdgcn_mfma_f32_16x16x32_bf16(Vf[db], Pf, O[qb][db], 0, 0, 0);
    }
}
__device__ __forceinline__ void attn_tile(const bf16x8 (&Kf)[2][2], const bf16x8 (&Qf)[2][2], LAS unsigned short* vt, f32x4 (&O)[2][4], float (&R)[2], bool diag, int c16, int g) {
    attn_tile_t(Kf, Qf, vt, O, R, diag, c16, g);
}
#define WAVE_LDS_SYNC() do { asm volatile("" ::: "memory"); __builtin_amdgcn_wave_barrier(); asm volatile("" ::: "memory"); } while (0)

__device__ __forceinline__ void attn_item(const Params& p, int item, const bf16_t* __restrict__ qkvb, bf16_t* __restrict__ concat, LAS unsigned short* vt, int lane) {
    const bool prompt = item < 4096;
    int b, h, qt;
    if (prompt) { qt = item & 127; h = (item >> 7) & 7; b = item >> 10; } else { const int s = item - 4096; h = s & 7; b = s >> 3; qt = 0; }
    const size_t rowq = (prompt ? (size_t)b * SEQ : (size_t)MP + b * DSEQ) + qt * 32;
    const int qpos0 = (prompt ? 0 : PAST) + qt * 32;
    const int c16 = lane & 15, g = lane >> 4;
    bf16x8 Qf[2][2];
#pragma unroll
    for (int qb = 0; qb < 2; ++qb)
#pragma unroll
        for (int dh = 0; dh < 2; ++dh) Qf[qb][dh] = *(const bf16x8*)(qkvb + (rowq + qb * 16 + c16) * 1536 + h * 64 + dh * 32 + g * 8);
    f32x4 O[2][4];
#pragma unroll
    for (int qb = 0; qb < 2; ++qb)
#pragma unroll
        for (int db = 0; db < 4; ++db) O[qb][db] = (f32x4){0.f, 0.f, 0.f, 0.f};
    float R[2] = {0.f, 0.f};
    const int key = lane >> 1, dhalf = (lane & 1) * 32;
    {
        for (int kt = qpos0 >> 5; kt >= 0; --kt) {
            const int kp0 = kt << 5;
            bf16x8 Kf[2][2];
            if (prompt || kp0 >= PAST) {
                const size_t krow = prompt ? (size_t)b * SEQ + kp0 : (size_t)MP + b * DSEQ + (kp0 - PAST);
#pragma unroll
                for (int kb = 0; kb < 2; ++kb)
#pragma unroll
                    for (int dh = 0; dh < 2; ++dh) Kf[kb][dh] = *(const bf16x8*)(qkvb + (krow + kb * 16 + c16) * 1536 + 512 + h * 64 + dh * 32 + g * 8);
                const bf16_t* vp = qkvb + (krow + key) * 1536 + 1024 + h * 64 + dhalf;
#pragma unroll
                for (int i = 0; i < 4; ++i) {
                    const bf16x8 v = *(const bf16x8*)(vp + i * 8);
#pragma unroll
                    for (int e = 0; e < 8; ++e) vt[(dhalf + i * 8 + e) * 36 + key] = (unsigned short)v[e];
                }
            } else {
                const float* kp = p.ck + ((size_t)(b * PAST + kp0) * 8 + h) * 64;
#pragma unroll
                for (int kb = 0; kb < 2; ++kb)
#pragma unroll
                    for (int dh = 0; dh < 2; ++dh) {
                        const float* sp_ = kp + (size_t)(kb * 16 + c16) * 512 + dh * 32 + g * 8;
                        const f32x4 a = *(const f32x4*)sp_, bb = *(const f32x4*)(sp_ + 4);
                        u32x4 o; o.x = pk_bf16(a[0], a[1]); o.y = pk_bf16(a[2], a[3]); o.z = pk_bf16(bb[0], bb[1]); o.w = pk_bf16(bb[2], bb[3]);
                        Kf[kb][dh] = __builtin_bit_cast(bf16x8, o);
                    }
                const float* vp = p.cv + ((size_t)(b * PAST + kp0 + key) * 8 + h) * 64 + dhalf;
#pragma unroll
                for (int i = 0; i < 8; ++i) {
                    const f32x4 v = *(const f32x4*)(vp + i * 4);
#pragma unroll
                    for (int e = 0; e < 4; ++e) vt[(dhalf + i * 4 + e) * 36 + key] = f2bf(v[e]);
                }
            }
            WAVE_LDS_SYNC();
            attn_tile(Kf, Qf, vt, O, R, kp0 == qpos0, c16, g);
            WAVE_LDS_SYNC();
            if (__all(fminf(R[0], R[1]) > R_EXIT)) break;
        }
    }
#pragma unroll
    for (int qb = 0; qb < 2; ++qb)
#pragma unroll
        for (int db = 0; db < 4; ++db)
            *(u32x2*)(concat + (rowq + qb * 16 + c16) * DM + h * 64 + db * 16 + g * 4) = pk4(O[qb][db]);
}

template <int G>
__device__ __forceinline__ void pool_item_g(const Params& p, int tokblk, const bf16_t* __restrict__ ubuf, const bf16_t* __restrict__ pwT, bf16_t* __restrict__ concat, LAS bf16_t* dt, int lane) {
    constexpr int W = 2 << G;
    const int r0 = tokblk * 16;
    int t0, start; size_t rb; const float* hist;
    if (r0 < MP) { t0 = r0 & (SEQ - 1); rb = (size_t)(r0 - t0); start = 0; hist = nullptr; }
    else { const int rr = r0 - MP; const int b = rr >> 5; t0 = rr & 31; rb = (size_t)MP + b * DSEQ; start = PAST; hist = p.sp + (size_t)b * 15 * 512; }
    const int c16 = lane & 15, gq = lane >> 4;
    const bf16_t* wbase = pwT + (size_t)G * 16384 + (size_t)c16 * 128 + gq * 8;
    float v[2][15 + W];
#pragma unroll
    for (int half = 0; half < 2; ++half) {
        const int ch = G * 128 + half * 64 + lane;
#pragma unroll
        for (int i = 0; i < 15 + W; ++i) {
            const int t = t0 - (W - 1) + i;
            const int tc = (t >= 0) ? t : 0;
            const float xu = bf2f(ubuf[(rb + tc) * 512 + ch]);
            const float xh = (t < 0 && hist) ? hist[(size_t)(15 + t) * 512 + ch] : 0.f;
            v[half][i] = (t >= 0) ? xu : xh;
        }
    }
#pragma unroll
    for (int half = 0; half < 2; ++half) {
        float s = 0.f;
#pragma unroll
        for (int i = 0; i < W - 1; ++i) s += v[half][i];
#pragma unroll
        for (int i = 0; i < 16; ++i) {
            const float cur = v[half][W - 1 + i];
            s += cur;
            const int cnt = min(W, start + t0 + i + 1);
            const float d = s / (float)cnt - cur;
            dt[i * 136 + half * 64 + lane] = f2bf(d);
            s -= v[half][i];
        }
    }
    WAVE_LDS_SYNC();
    f32x4 acc[8];
    bf16x8 bfrag[4];
#pragma unroll
    for (int ks = 0; ks < 4; ++ks) bfrag[ks] = *(const LAS bf16x8*)(dt + c16 * 136 + ks * 32 + gq * 8);
    const bf16_t* wp = wbase;
    asm volatile("" : "+v"(wp));
    bf16x8 wa[8][4];
#pragma unroll
    for (int nb = 0; nb < 8; ++nb)
#pragma unroll
        for (int ks = 0; ks < 4; ++ks) wa[nb][ks] = *(const bf16x8*)(wp + (size_t)nb * 16 * 128 + ks * 32);
    asm volatile("" ::: "memory");
#pragma unroll
    for (int nb = 0; nb < 8; ++nb) {
        acc[nb] = (f32x4){0.f, 0.f, 0.f, 0.f};
#pragma unroll
        for (int ks = 0; ks < 4; ++ks) acc[nb] = __builtin_amdgcn_mfma_f32_16x16x32_bf16(wa[nb][ks], bfrag[ks], acc[nb], 0, 0, 0);
    }
    const int row = r0 + c16;
#pragma unroll
    for (int nb = 0; nb < 8; ++nb) {
        const int dout = G * 128 + nb * 16 + gq * 4;
        const f32x4 sc = *(const f32x4*)(p.pool_scale + dout);
        *(u32x2*)(concat + (size_t)row * DM + 512 + dout) = pk4(acc[nb] * sc);
    }
    WAVE_LDS_SYNC();
}

constexpr int P2_ITEMS = 8320, P2_PER_Q = P2_ITEMS / 8;
__device__ __forceinline__ void phase2(const Params& p, LAS unsigned char* lds, const bf16_t* qkvb, const bf16_t* ubuf, bf16_t* concat) {
    const int tid = threadIdx.x, wave = tid >> 6, lane = tid & 63;
    LAS unsigned short* wl = (LAS unsigned short*)(lds + wave * 4608);
    unsigned* ctr = (unsigned*)(p.ws + WS_BAR + 14336);
    const bf16_t* pwT = (const bf16_t*)(p.ws + WS_PWT);
    const int q0 = blockIdx.x & 7;
    for (int qq = 0; qq < 8; ++qq) {
        const int qi = (q0 + qq) & 7;
        for (;;) {
            unsigned i = 0;
            if (lane == 0) i = __hip_atomic_fetch_add(ctr + qi * 64, 1u, __ATOMIC_RELAXED, __HIP_MEMORY_SCOPE_AGENT);
            i = (unsigned)__builtin_amdgcn_readfirstlane((int)i);
            if (i >= (unsigned)P2_PER_Q) break;
            const int j = (int)i >> 1;
            const int item = ((int)i & 1) ? 4160 + qi * 520 + j : (j < 8 ? 4096 + qi * 8 + j : qi * 512 + (j - 8));
            if (item < 4160) attn_item(p, item, qkvb, concat, wl, lane);
            else {
                const int j = item - 4160, tokblk = j >> 2, g = j & 3;
                LAS bf16_t* dt = (LAS bf16_t*)wl;
                if (g == 0) pool_item_g<0>(p, tokblk, ubuf, pwT, concat, dt, lane);
                else if (g == 1) pool_item_g<1>(p, tokblk, ubuf, pwT, concat, dt, lane);
                else if (g == 2) pool_item_g<2>(p, tokblk, ubuf, pwT, concat, dt, lane);
                else pool_item_g<3>(p, tokblk, ubuf, pwT, concat, dt, lane);
            }
        }
    }
    (void)ctr;
}

__global__ void __launch_bounds__(512, 2) fwd_megakernel(Params p) {
    __shared__ __attribute__((aligned(16))) unsigned char smem[pg8::STAGE_BYTES];
    LAS unsigned char* lds = (LAS unsigned char*)smem;
    cg::grid_group grid = cg::this_grid();
    __shared__ uint4 xb_words;
    if (threadIdx.x == 0) xb_words = make_uint4(0u, 0u, 0u, 0u);
    __syncthreads();
    const XcdBarrier gbar = xcd_barrier_post((unsigned*)(p.ws + WS_BAR), (volatile LAS unsigned*)&xb_words);
    const int tid = threadIdx.x, bid = blockIdx.x, nb = gridDim.x;
    bf16_t* xb = (bf16_t*)(p.ws + WS_A); bf16_t* hid = (bf16_t*)(p.ws + WS_A);
    bf16_t* qkvb = (bf16_t*)(p.ws + WS_B); bf16_t* pb16 = (bf16_t*)(p.ws + WS_B); bf16_t* ubuf = (bf16_t*)(p.ws + WS_UB);
    bf16_t* concat = (bf16_t*)(p.ws + WS_C);
    float* st1 = (float*)(p.ws + WS_ST1); float* st2 = (float*)(p.ws + WS_ST2);
#ifndef PHMASK
#define PHMASK 127
#endif
#ifndef REPMASK
#define REPMASK 0
#endif
#ifndef REPBAR
#define REPBAR 0
#endif
#define PH_RUN(k, lam) if ((PHMASK & (1 << (k))) && p.ph_lo <= (k) && (k) < p.ph_hi) { if ((k) > p.ph_lo) { if (p.ph_lo < 0) grid.sync(); else xcd_barrier(gbar); } \
        if ((REPMASK >> (k)) & 1) { lam(true); if (REPBAR) xcd_barrier(gbar); else __syncthreads(); } lam(false); }
    float* const dummy_st = (float*)(p.ws + WS_END);
    float* const scratch_y = (float*)(p.ws + WS_B + (size_t)MT * DM * 2);
    auto ph0 = [&](bool) { phase0(p, lds); };
    auto ph1 = [&](bool) {
        pg8::StaticOrder S; S.init(MP, NIN, nb, bid);
        EpiIn E{qkvb, ubuf, p.out};
        pg8::gemm_phase(lds, pg8::Gemm{xb, (const bf16_t*)(p.ws + WS_WIN), MP, NIN, DM}, S, E);
        mini_gemm_phase(lds, xb, (const bf16_t*)(p.ws + WS_WIN), DM, NIN / 64, 0, nb < 128 ? nb : 128, E);
    };
    auto ph2 = [&](bool) { phase2(p, lds, qkvb, ubuf, concat); };
    auto ph3 = [&](bool probe) {
        pg8::StaticOrder S; S.init(MP, DM, nb, bid);
        EpiOut E{xb, pb16, probe ? dummy_st : st1};
        pg8::gemm_phase(lds, pg8::Gemm{concat, (const bf16_t*)(p.ws + WS_WOUT), MP, DM, DM}, S, E);
        mini_gemm_phase(lds, concat, (const bf16_t*)(p.ws + WS_WOUT), DM, DM / 64, 0, nb < 64 ? nb : 64, E);
    };
    auto ph4 = [&](bool) {
        pg8::StaticOrder S; S.init(MP, NGU, nb, bid);
        EpiGU E{st1, (const float*)(p.ws + WS_CS), (const float*)(p.ws + WS_BW), hid};
        pg8::gemm_phase(lds, pg8::Gemm{pb16, (const bf16_t*)(p.ws + WS_WGU), MP, NGU, DM}, S, E);
        mini_gemm_phase(lds, pb16, (const bf16_t*)(p.ws + WS_WGU), DM, DFF / 32, nb == 256 ? 128 : 0, nb == 256 ? 128 : nb, E);
    };
    const bool fuse_ln2 = (nb == MP / 256 * (DM / 256)) && !((REPMASK >> 5) & 1);
    auto ph5f = [&](bool) {
        pg8::StaticOrder S; S.init(MP, DM, nb, bid);
        EpiDownF E{pb16, st1, p.ln1g, p.ln1b, st2, p.out + OFF_YP, p.ln2g, p.ln2b, (unsigned*)(p.ws + WS_BAR + 16384)};
        pg8::gemm_phase(lds, pg8::Gemm{hid, (const bf16_t*)(p.ws + WS_WD), MP, DM, DFF}, S, E);
        mini_gemm_phase(lds, hid, (const bf16_t*)(p.ws + WS_WD), DFF, DM / 64, 0, 64, E);
    };
    auto ph5 = [&](bool probe) {
        if (fuse_ln2) { ph5f(probe); return; }
        pg8::StaticOrder S; S.init(MP, DM, nb, bid);
        EpiDown E{pb16, st1, p.ln1g, p.ln1b, probe ? dummy_st : st2, probe ? scratch_y : p.out + OFF_YP};
        pg8::gemm_phase(lds, pg8::Gemm{hid, (const bf16_t*)(p.ws + WS_WD), MP, DM, DFF}, S, E);
        mini_gemm_phase(lds, hid, (const bf16_t*)(p.ws + WS_WD), DFF, DM / 64, 0, nb < 64 ? nb : 64, E);
    };
    auto ph6 = [&](bool probe) {
        f32x4* y4 = (f32x4*)(p.out + OFF_YP);
        f32x4* yo4 = probe ? (f32x4*)scratch_y : y4;
        const size_t n4 = (size_t)MT * DM / 4;
        for (size_t i = (size_t)bid * 512 + tid; i < n4; i += (size_t)nb * 512) {
            const int r = (int)(i >> 8), c4 = (int)(i & 255);
            const float s = st2[2 * r], q = st2[2 * r + 1];
            const float mu = s * (1.0f / DM); const float var = q * (1.0f / DM) - mu * mu; const float rstd = rsqrtf(var + LN_EPS);
            const f32x4 v = y4[i], gv = ((const f32x4*)p.ln2g)[c4], bv = ((const f32x4*)p.ln2b)[c4];
            yo4[i] = (v - mu) * rstd * gv + bv;
        }
    };
    PH_RUN(0, ph0) PH_RUN(1, ph1) PH_RUN(2, ph2) PH_RUN(3, ph3) PH_RUN(4, ph4) PH_RUN(5, ph5) if (!fuse_ln2) { PH_RUN(6, ph6) }
}

extern "C" void kernel_launch(void* const* d_in, const int* in_sizes, int n_in, void* d_out, int out_size, void* d_ws, size_t ws_size, hipStream_t stream) {
    static int grid_blocks = 0;
    if (!grid_blocks) {
        int dev = 0, cus = 0, per_cu = 0;
        hipGetDevice(&dev);
        hipDeviceGetAttribute(&cus, hipDeviceAttributeMultiprocessorCount, dev);
        hipOccupancyMaxActiveBlocksPerMultiprocessor(&per_cu, fwd_megakernel, 512, 0);
        if (per_cu < 1) { fprintf(stderr, "occupancy query says %d blocks/CU\n", per_cu); per_cu = 1; }
        if (per_cu > 1) per_cu = 1;
        grid_blocks = cus * per_cu;
        if (ws_size < WS_END) fprintf(stderr, "workspace too small: %zu < %zu\n", ws_size, (size_t)WS_END);
    }
    Params p{};
    p.xp = (const float*)d_in[0]; p.xs = (const float*)d_in[1]; p.ck = (const float*)d_in[2]; p.cv = (const float*)d_in[3]; p.sp = (const float*)d_in[4];
    p.w_in = (const float*)d_in[5]; p.pool_w = (const float*)d_in[6]; p.pool_scale = (const float*)d_in[7]; p.w_out = (const float*)d_in[8];
    p.ln1g = (const float*)d_in[9]; p.ln1b = (const float*)d_in[10]; p.wg = (const float*)d_in[11]; p.wu = (const float*)d_in[12]; p.wd = (const float*)d_in[13];
    p.ln2g = (const float*)d_in[14]; p.ln2b = (const float*)d_in[15];
    p.out = (float*)d_out; p.ws = (unsigned char*)d_ws;
    (void)hipMemsetAsync((unsigned char*)d_ws + WS_BAR, 0, WS_BAR_BYTES, stream);
#if MULTI_LAUNCH
    for (int ph = 0; ph < 7; ++ph) { p.ph_lo = ph; p.ph_hi = ph + 1; hipLaunchKernelGGL(fwd_megakernel, dim3(grid_blocks), dim3(512), 0, stream, p); }
#else
    p.ph_lo = 0; p.ph_hi = 7;
    void* args[] = {&p};
    hipError_t e = hipLaunchCooperativeKernel((void*)fwd_megakernel, dim3(grid_blocks), dim3(512), args, 0, stream);
    if (e != hipSuccess) fprintf(stderr, "cooperative launch failed: %s (grid %d)\n", hipGetErrorString(e), grid_blocks);
#endif
}
```

```cpp
#include <hip/hip_runtime.h>
#include <hip/hip_cooperative_groups.h>
#include <cstdio>
namespace cg = cooperative_groups;

#ifndef MULTI_LAUNCH
#define MULTI_LAUNCH 0
#endif

#define LAS __attribute__((address_space(3)))
typedef unsigned short bf16_t;
typedef short bf16x8 __attribute__((ext_vector_type(8)));
typedef float f32x4 __attribute__((ext_vector_type(4)));
typedef unsigned u32x2 __attribute__((ext_vector_type(2)));
typedef unsigned u32x4 __attribute__((ext_vector_type(4)));

constexpr int MP = 16384, MS = 256, MT = MP + MS;
constexpr int DM = 1024, NIN = 2048, DFF = 2816, NGU = 2 * DFF;
constexpr int SEQ = 4096, DSEQ = 32, PAST = 2048;
constexpr float ALPHA = 1.189207115002721f;
constexpr float LN_EPS = 1e-5f;
constexpr float R_EXIT = 130.0f;

constexpr size_t OFF_YP = 0, OFF_YS = 16777216, OFF_KP = 17039360, OFF_VP = 25427968, OFF_PP = 33816576,
                 OFF_KS = 33847296, OFF_VS = 33978368, OFF_PS = 34109440;

constexpr size_t WS_WIN = 0;
constexpr size_t WS_WOUT = WS_WIN + (size_t)NIN * DM * 2;
constexpr size_t WS_WGU = WS_WOUT + (size_t)DM * DM * 2;
constexpr size_t WS_WD = WS_WGU + (size_t)NGU * DM * 2;
constexpr size_t WS_PWT = WS_WD + (size_t)DM * DFF * 2;
constexpr size_t WS_CS = WS_PWT + 4 * 128 * 128 * 2;
constexpr size_t WS_BW = WS_CS + (size_t)NGU * 4;
constexpr size_t WS_ST1 = WS_BW + (size_t)NGU * 4;
constexpr size_t WS_ST2 = WS_ST1 + (size_t)MT * 2 * 4;
constexpr size_t WS_BAR = WS_ST2 + (size_t)MT * 2 * 4;
constexpr size_t WS_BAR_BYTES = 36864;
constexpr size_t WS_A = 24117248;
constexpr size_t WS_B = WS_A + (size_t)MT * DFF * 2;
constexpr size_t WS_UB = WS_B + (size_t)MT * 1536 * 2;
constexpr size_t WS_C = WS_UB + (size_t)MT * 512 * 4;
constexpr size_t WS_END = WS_C + (size_t)MT * DM * 2;
static_assert(WS_BAR + WS_BAR_BYTES <= WS_A, "ws map");
static_assert(WS_END <= 268435456ull, "ws map");

struct Params {
    const float *xp, *xs, *ck, *cv, *sp, *w_in, *pool_w, *pool_scale, *w_out, *ln1g, *ln1b, *wg, *wu, *wd, *ln2g, *ln2b;
    float* out; unsigned char* ws; int ph_lo, ph_hi;
};

__device__ __forceinline__ unsigned pk_bf16(float lo, float hi) { unsigned r; asm("v_cvt_pk_bf16_f32 %0, %1, %2" : "=v"(r) : "v"(lo), "v"(hi)); return r; }
__device__ __forceinline__ bf16_t f2bf(float f) { unsigned u = __float_as_uint(f); u += 0x7FFFu + ((u >> 16) & 1u); return (bf16_t)(u >> 16); }
__device__ __forceinline__ float bf2f(bf16_t b) { return __uint_as_float(((unsigned)b) << 16); }
__device__ __forceinline__ f32x4 up4(u32x2 w) { f32x4 v; v[0] = __uint_as_float(w.x << 16); v[1] = __uint_as_float(w.x & 0xffff0000u); v[2] = __uint_as_float(w.y << 16); v[3] = __uint_as_float(w.y & 0xffff0000u); return v; }
__device__ __forceinline__ u32x2 pk4(f32x4 v) { u32x2 o; o.x = pk_bf16(v[0], v[1]); o.y = pk_bf16(v[2], v[3]); return o; }


#define XB_TMO      128
#define XB_XCNT(j)  (256  + 64 * (j))
#define XB_XSUB(j)  (1280 + 64 * (j))
#define XB_XGEN(j)  (2304 + 64 * (j))
#define XB_TOP      3328
#define XB_TOPGEN   3392
#define XCD_BAR_WORDS 3456
#define XB_SPIN_CAP (1u << 22)
__device__ __forceinline__ unsigned xb_ld(unsigned* p)              { return __hip_atomic_load(p, __ATOMIC_RELAXED, __HIP_MEMORY_SCOPE_AGENT); }
__device__ __forceinline__ unsigned xb_add(unsigned* p, unsigned v) { return __hip_atomic_fetch_add(p, v, __ATOMIC_RELAXED, __HIP_MEMORY_SCOPE_AGENT); }
__device__ __forceinline__ unsigned xb_xcc_id() { return (unsigned)__builtin_amdgcn_s_getreg((3 << 11) | 20) & 0xFu; }
#define XB_SPIN(cond, bar) do { unsigned _sp = 0; while (cond) { __builtin_amdgcn_s_sleep(1); \
    if ((++_sp & 255u) == 0u) { if (xb_ld(&(bar)[XB_TMO])) break; if (_sp > XB_SPIN_CAP) { atomicAdd(&(bar)[XB_TMO], 1u); break; } } } } while (0)
struct XcdBarrier { unsigned* bar; unsigned x; volatile LAS unsigned* st; };
__device__ __forceinline__ XcdBarrier xcd_barrier_post(unsigned* bar, volatile LAS unsigned* st) {
    XcdBarrier b; b.bar = bar; b.x = xb_xcc_id(); b.st = st;
    if (threadIdx.x == 0) (void)xb_add(&bar[XB_XCNT(b.x)], 1u);
    return b;
}
__device__ __forceinline__ void xcd_barrier_complete(unsigned* bar, unsigned x, unsigned& nloc, unsigned& nx) {
    const unsigned G = gridDim.x * gridDim.y * gridDim.z;
    unsigned sum, cnt, mine, sp = 0u;
    for (;;) {
        sum = 0u; cnt = 0u; mine = 0u;
#pragma unroll
        for (unsigned j = 0; j < 16; ++j) { const unsigned c = xb_ld(&bar[XB_XCNT(j)]); sum += c; cnt += (c > 0u) ? 1u : 0u; mine = (j == x) ? c : mine; }
        if (sum == G) break;
        __builtin_amdgcn_s_sleep(1);
        if ((++sp & 255u) == 0u) { if (xb_ld(&bar[XB_TMO])) break; if (sp > XB_SPIN_CAP) { atomicAdd(&bar[XB_TMO], 1u); break; } }
    }
    nloc = mine > 0u ? mine : 1u; nx = cnt > 0u ? cnt : 1u;
}
__device__ __forceinline__ void xcd_barrier(const XcdBarrier& b) {
    asm volatile("s_waitcnt vmcnt(0)" ::: "memory");
    __syncthreads();
    if (threadIdx.x == 0) {
        unsigned* bar = b.bar;
        __builtin_amdgcn_s_waitcnt(0);
        unsigned nloc = b.st[0], nx = b.st[1];
        if (nloc == 0u) { xcd_barrier_complete(bar, b.x, nloc, nx); b.st[0] = nloc; b.st[1] = nx; }
        const unsigned old = xb_add(&bar[XB_XSUB(b.x)], 1u);
        const unsigned gen = old / nloc;
        if (old + 1u == (gen + 1u) * nloc) {
            __builtin_amdgcn_fence(__ATOMIC_RELEASE, "agent");
            asm volatile("s_waitcnt vmcnt(0)" ::: "memory");
            const unsigned og = xb_add(&bar[XB_TOP], 1u);
            const unsigned tg = og / nx;
            if (og + 1u == (tg + 1u) * nx) xb_add(&bar[XB_TOPGEN], 1u);
            else XB_SPIN(xb_ld(&bar[XB_TOPGEN]) == tg, bar);
            __builtin_amdgcn_fence(__ATOMIC_ACQUIRE, "agent");
            xb_add(&bar[XB_XGEN(b.x)], 1u);
            asm volatile("s_waitcnt vmcnt(0)" ::: "memory");
        } else {
            XB_SPIN(xb_ld(&bar[XB_XGEN(b.x)]) == gen, bar);
            __builtin_amdgcn_fence(__ATOMIC_ACQUIRE, "agent");
            asm volatile("s_waitcnt vmcnt(0)" ::: "memory");
        }
    }
    __syncthreads();
}

namespace pg8 {
constexpr int BM = 256, BK = 64, HALF = 128, HTB = HALF * BK * 2, STAGE_BYTES = 8 * HTB, NXCD = 8, WGM = 8;
__device__ __forceinline__ int lds_byte(int r, int c) { const int st = (r >> 4) * 2 + (c >> 5), rr = r & 15, cc = c & 31, ob = rr * 64 + cc * 2; return st * 1024 + (ob ^ (((ob >> 9) & 1) << 5)); }
__device__ __forceinline__ void stage_rc(int b, int& R, int& C) { const int st = b / 1024, sb = b % 1024, swz = sb ^ (((sb >> 9) & 1) << 5); R = (st >> 1) * 16 + swz / 64; C = (st & 1) * 32 + (swz % 64) / 2; }
struct Unit { int pm, pn; };
struct Gemm { const bf16_t* A; const bf16_t* Bt; int M, N, K; };
struct StaticOrder {
    int nM, nN, nwg, G, c;
    __device__ void init(int M, int N, int G_, int c_) { nM = M / BM; nN = N / BM; nwg = nM * nN; G = G_; c = c_; }
    __device__ bool next(int i, Unit& u) const {
        const long L = (long)i * G + c; if (L >= nwg) return false;
        int wgid = (int)L; { const int q = nwg / NXCD, r = nwg % NXCD, xcd = wgid % NXCD, off = wgid / NXCD; wgid = (xcd < r ? xcd * (q + 1) : r * (q + 1) + (xcd - r) * q) + off; }
        const int nig = WGM * nN, gid = wgid / nig, fm = gid * WGM, gsz = (nM - fm) < WGM ? (nM - fm) : WGM;
        u.pm = fm + ((wgid % nig) % gsz); u.pn = (wgid % nig) / gsz; return true;
    }
};

template <class Epi>
__device__ __forceinline__ void gemm_phase(LAS unsigned char* lds, const Gemm g, const StaticOrder& S, const Epi& E) {
    const int tid = threadIdx.x, wid = __builtin_amdgcn_readfirstlane(tid >> 6), lane = tid & 63, wr = wid >> 2, wc = wid & 3, fr = lane & 15, fq = lane >> 4;
    int K_ = g.K; asm volatile("" : "+s"(K_));
    const int K = K_, nt = K / BK;
    unsigned voffA[2];
#pragma unroll
    for (int i = 0; i < 2; ++i) { int R, C; stage_rc(tid * 16 + i * 8192, R, C); voffA[i] = (unsigned)(R * K + C) * 2u; }
    const size_t kstep = (size_t)(BK * 2);
    const size_t hstep = (size_t)HALF * K * 2;
    const size_t tstep = 2 * hstep;
    const unsigned ldsw = (unsigned)wid * 1024u;
    const int aoff = lds_byte(wr * 64 + fr, fq * 8), boff = lds_byte(wc * 32 + fr, fq * 8);
#define PG8_SA(b, h) (((b) * 2 + (h)) * HTB)
#define PG8_SB(b, h) ((4 + (b) * 2 + (h)) * HTB)
#define PG8_STAGE(bufoff, gbase, voff) do { _Pragma("unroll") for (int _i = 0; _i < 2; ++_i) \
        __builtin_amdgcn_global_load_lds((const unsigned*)((const char*)(gbase) + (voff)[_i]), (LAS unsigned*)(lds + (bufoff) + ldsw + _i * 8192), 16, 0, 0); } while (0)
#define PG8_LDA(dst, b, h) do { _Pragma("unroll") for (int m = 0; m < 4; ++m) _Pragma("unroll") for (int k = 0; k < 2; ++k) dst[m][k] = *(const LAS bf16x8*)(lds + PG8_SA(b, h) + aoff + m * 2048 + k * 1024); } while (0)
#define PG8_LDB(dst, b, h) do { _Pragma("unroll") for (int n = 0; n < 2; ++n) _Pragma("unroll") for (int k = 0; k < 2; ++k) dst[n][k] = *(const LAS bf16x8*)(lds + PG8_SB(b, h) + boff + n * 2048 + k * 1024); } while (0)
#define PG8_MMA(ai, bj, At, Bt) do { __builtin_amdgcn_s_setprio(1); _Pragma("unroll") for (int m = 0; m < 4; ++m) _Pragma("unroll") for (int n = 0; n < 2; ++n) _Pragma("unroll") for (int k = 0; k < 2; ++k) \
        acc[ai][bj][m][n] = __builtin_amdgcn_mfma_f32_16x16x32_bf16(Bt[n][k], At[m][k], acc[ai][bj][m][n], 0, 0, 0); __builtin_amdgcn_s_setprio(0); } while (0)
#define PG8_WAIT_V(n) asm volatile("s_waitcnt vmcnt(" #n ")" ::: "memory")
#define PG8_WAIT_L(n) asm volatile("s_waitcnt lgkmcnt(" #n ")" ::: "memory")
#define PG8_BAR __builtin_amdgcn_s_barrier()
#define PG8_SCHED __builtin_amdgcn_sched_barrier(0)
    Unit cur, nxt; int ui = 0;
    if (!S.next(0, cur)) return;
    f32x4 acc[2][2][4][2];
#pragma unroll
    for (int a = 0; a < 2; ++a)
#pragma unroll
        for (int b = 0; b < 2; ++b)
#pragma unroll
            for (int m = 0; m < 4; ++m)
#pragma unroll
                for (int n = 0; n < 2; ++n) acc[a][b][m][n] = (f32x4){0.f, 0.f, 0.f, 0.f};
    bf16x8 At[4][2], B0[2][2], B1[2][2];
    const char* cA = (const char*)g.A + (size_t)cur.pm * tstep; const char* cB = (const char*)g.Bt + (size_t)cur.pn * tstep;
    PG8_STAGE(PG8_SB(0, 0), cB, voffA); PG8_STAGE(PG8_SA(0, 0), cA, voffA); PG8_STAGE(PG8_SB(0, 1), cB + hstep, voffA); PG8_STAGE(PG8_SA(0, 1), cA + hstep, voffA);
    if (wr == 1) PG8_BAR;
    PG8_WAIT_V(4); PG8_BAR;
    PG8_STAGE(PG8_SB(1, 0), cB + kstep, voffA); PG8_STAGE(PG8_SA(1, 0), cA + kstep, voffA); PG8_STAGE(PG8_SB(1, 1), cB + hstep + kstep, voffA);
    PG8_WAIT_V(6); PG8_BAR;
    for (;;) {
        const bool has_next = S.next(ui + 1, nxt);
        const char* nA = has_next ? (const char*)g.A + (size_t)nxt.pm * tstep : cA; const char* nB = has_next ? (const char*)g.Bt + (size_t)nxt.pn * tstep : cB;
        for (int t = 0; t < nt; t += 2) {
            const bool last = (t == nt - 2);
            const char* a1 = cA + (size_t)(t + 1) * kstep;
            const char* a2 = last ? nA : cA + (size_t)(t + 2) * kstep; const char* b2 = last ? nB : cB + (size_t)(t + 2) * kstep;
            const char* a3 = a2 + kstep; const char* b3 = b2 + kstep;
            PG8_LDB(B0, 0, 0); PG8_SCHED; PG8_LDA(At, 0, 0); PG8_STAGE(PG8_SA(1, 1), a1 + hstep, voffA);
            PG8_WAIT_L(8); PG8_BAR; PG8_WAIT_L(0); PG8_MMA(0, 0, At, B0); PG8_BAR; PG8_SCHED;
            PG8_LDB(B1, 0, 1); PG8_STAGE(PG8_SB(0, 0), b2, voffA);
            PG8_BAR; PG8_WAIT_L(0); PG8_MMA(0, 1, At, B1); PG8_BAR;
            PG8_LDA(At, 0, 1); PG8_STAGE(PG8_SA(0, 0), a2, voffA);
            PG8_BAR; PG8_WAIT_L(0); PG8_MMA(1, 0, At, B0); PG8_BAR; PG8_SCHED;
            PG8_STAGE(PG8_SB(0, 1), b2 + hstep, voffA);
            PG8_WAIT_V(6); PG8_BAR; PG8_MMA(1, 1, At, B1); PG8_BAR;
            PG8_LDB(B0, 1, 0); PG8_SCHED; PG8_LDA(At, 1, 0); PG8_STAGE(PG8_SA(0, 1), a2 + hstep, voffA);
            PG8_WAIT_L(8); PG8_BAR; PG8_WAIT_L(0); PG8_MMA(0, 0, At, B0); PG8_BAR; PG8_SCHED;
            PG8_LDB(B1, 1, 1); PG8_STAGE(PG8_SB(1, 0), b3, voffA);
            PG8_BAR; PG8_WAIT_L(0); PG8_MMA(0, 1, At, B1); PG8_BAR;
            PG8_LDA(At, 1, 1); PG8_STAGE(PG8_SA(1, 0), a3, voffA);
            PG8_BAR; PG8_WAIT_L(0); PG8_MMA(1, 0, At, B0); PG8_BAR; PG8_SCHED;
            PG8_STAGE(PG8_SB(1, 1), b3 + hstep, voffA);
            PG8_WAIT_V(6); PG8_BAR; PG8_MMA(1, 1, At, B1); PG8_BAR;
        }
        if constexpr (Epi::AFTER_DRAIN) { if (has_next) epi_main(E, acc, cur, wr, wc, fr, fq); }
        else epi_main(E, acc, cur, wr, wc, fr, fq);
        if (!has_next) break;
#pragma unroll
        for (int a = 0; a < 2; ++a)
#pragma unroll
            for (int b = 0; b < 2; ++b)
#pragma unroll
                for (int m = 0; m < 4; ++m)
#pragma unroll
                    for (int n = 0; n < 2; ++n) acc[a][b][m][n] = (f32x4){0.f, 0.f, 0.f, 0.f};
        cur = nxt; cA = nA; cB = nB; ++ui;
    }
    PG8_WAIT_V(0);
    if (wr == 0) PG8_BAR;
    PG8_BAR;
    if constexpr (Epi::AFTER_DRAIN) E.fused(acc, cur, wr, wc, fr, fq);
#undef PG8_SA
#undef PG8_SB
#undef PG8_STAGE
#undef PG8_LDA
#undef PG8_LDB
#undef PG8_MMA
#undef PG8_WAIT_V
#undef PG8_WAIT_L
#undef PG8_BAR
#undef PG8_SCHED
}
}
using pg8::Unit;

__device__ __forceinline__ void ln_stats(const float* st, int r, float& mu, float& rstd) {
    const float s = st[2 * r], q = st[2 * r + 1];
    mu = s * (1.0f / DM); const float var = q * (1.0f / DM) - mu * mu; rstd = rsqrtf(var + LN_EPS);
}
struct EpiIn {
    static constexpr bool GU = false, STATS = false, AFTER_DRAIN = false;
    bf16_t* qkvb; bf16_t* ubuf; float* out;
    struct Row {};
    __device__ __forceinline__ Row row_begin(int) const { return Row{}; }
    __device__ __forceinline__ f32x4 load(const Row&, int, int) const { return (f32x4){0.f, 0.f, 0.f, 0.f}; }
    __device__ __forceinline__ void vec(const Row&, int r, int c, f32x4 v, f32x4, float&, float&) const {
        const int seg = c >> 9;
        if (seg == 0) {
            *(u32x2*)(qkvb + (size_t)r * 1536 + c) = pk4(v * (0.125f * 1.4426950408889634f));
        } else if (seg < 3) {
            *(u32x2*)(qkvb + (size_t)r * 1536 + c) = pk4(v);
            const int isv = seg == 2; const int cc = c & 511;
            float* dst = (r < MP) ? out + (isv ? OFF_VP : OFF_KP) + (size_t)r * 512 + cc
                                  : out + (isv ? OFF_VS : OFF_KS) + (size_t)(r - MP) * 512 + cc;
            __builtin_nontemporal_store(v, (f32x4*)dst);
        } else {
            const int cc = c & 511;
            *(u32x2*)(ubuf + (size_t)r * 512 + cc) = pk4(v);
            if (r < MP) { const int t = r & (SEQ - 1), b = r >> 12; if (t >= SEQ - 15) *(f32x4*)(out + OFF_PP + (size_t)(b * 15 + t - (SEQ - 15)) * 512 + cc) = v; }
            else { const int rr = r - MP, b = rr >> 5, t = rr & 31; if (t >= DSEQ - 15) *(f32x4*)(out + OFF_PS + (size_t)(b * 15 + t - (DSEQ - 15)) * 512 + cc) = v; }
        }
    }
    __device__ __forceinline__ void row_end(int, float, float) const {}
};
struct EpiOut {
    static constexpr bool GU = false, STATS = true, AFTER_DRAIN = false;
    const bf16_t* xb; bf16_t* pb16; float* st;
    struct Row {};
    __device__ __forceinline__ Row row_begin(int) const { return Row{}; }
    __device__ __forceinline__ f32x4 load(const Row&, int r, int c) const { return up4(*(const u32x2*)(xb + (size_t)r * DM + c)); }
    __device__ __forceinline__ void vec(const Row&, int r, int c, f32x4 v, f32x4 xv, float& s, float& q) const {
        const f32x4 pv = xv * ALPHA + v;
        *(u32x2*)(pb16 + (size_t)r * DM + c) = pk4(pv);
        s += (pv[0] + pv[1]) + (pv[2] + pv[3]);
        q += (pv[0] * pv[0] + pv[1] * pv[1]) + (pv[2] * pv[2] + pv[3] * pv[3]);
    }
    __device__ __forceinline__ void row_end(int r, float s, float q) const { atomicAdd(st + 2 * r, s); atomicAdd(st + 2 * r + 1, q); }
};
struct EpiGU {
    static constexpr bool GU = true, STATS = false, AFTER_DRAIN = false;
    const float* st; const float* cs; const float* bw; bf16_t* hid;
    struct Row { float mu, rstd; };
    __device__ __forceinline__ Row row_begin(int r) const { Row R; ln_stats(st, r, R.mu, R.rstd); return R; }
    __device__ __forceinline__ void vec2(const Row& R, int r, int ff, int cgi, f32x4 ga, f32x4 ua) const {
        const f32x4 csg = *(const f32x4*)(cs + cgi), csu = *(const f32x4*)(cs + cgi + 128);
        const f32x4 bwg = *(const f32x4*)(bw + cgi), bwu = *(const f32x4*)(bw + cgi + 128);
        vec2c(R, r, ff, ga, ua, csg, csu, bwg, bwu);
    }
    __device__ __forceinline__ void vec2c(const Row& R, int r, int ff, f32x4 ga, f32x4 ua, f32x4 csg, f32x4 csu, f32x4 bwg, f32x4 bwu) const {
        const f32x4 gt = (ga - csg * R.mu) * R.rstd + bwg;
        const f32x4 up = (ua - csu * R.mu) * R.rstd + bwu;
        f32x4 hv;
#pragma unroll
        for (int e = 0; e < 4; ++e) hv[e] = gt[e] * __builtin_amdgcn_rcpf(1.0f + __expf(-gt[e])) * up[e];
        *(u32x2*)(hid + (size_t)r * DFF + ff) = pk4(hv);
    }
};
struct EpiDown {
    static constexpr bool GU = false, STATS = true, AFTER_DRAIN = false;
    const bf16_t* pb16; const float* st1; const float* g1; const float* b1; float* st2; float* yo;
    struct Row { float mu, rstd; };
    __device__ __forceinline__ Row row_begin(int r) const { Row R; ln_stats(st1, r, R.mu, R.rstd); return R; }
    __device__ __forceinline__ f32x4 load(const Row&, int r, int c) const { return up4(*(const u32x2*)(pb16 + (size_t)r * DM + c)); }
    __device__ __forceinline__ void vec(const Row& R, int r, int c, f32x4 v, f32x4 pv, float& s, float& q) const {
        const f32x4 gv = *(const f32x4*)(g1 + c), bv = *(const f32x4*)(b1 + c);
        const f32x4 x1 = (pv - R.mu) * R.rstd * gv + bv;
        const f32x4 o = x1 * ALPHA + v;
        *(f32x4*)(yo + (size_t)r * DM + c) = o;
        s += (o[0] + o[1]) + (o[2] + o[3]);
        q += (o[0] * o[0] + o[1] * o[1]) + (o[2] * o[2] + o[3] * o[3]);
    }
    __device__ __forceinline__ void row_end(int r, float s, float q) const { atomicAdd(st2 + 2 * r, s); atomicAdd(st2 + 2 * r + 1, q); }
};

__device__ __forceinline__ void panel_meet(unsigned* cnt, unsigned want) {
    asm volatile("s_waitcnt vmcnt(0)" ::: "memory");
    __syncthreads();
    if (threadIdx.x == 0) {
        __builtin_amdgcn_fence(__ATOMIC_RELEASE, "agent");
        asm volatile("s_waitcnt vmcnt(0)" ::: "memory");
        __hip_atomic_fetch_add(cnt, 1u, __ATOMIC_RELAXED, __HIP_MEMORY_SCOPE_AGENT);
        unsigned sp = 0;
        while (__hip_atomic_load(cnt, __ATOMIC_RELAXED, __HIP_MEMORY_SCOPE_AGENT) < want) { __builtin_amdgcn_s_sleep(1); if (++sp > (1u << 24)) break; }
    }
    __syncthreads();
}
__device__ __forceinline__ void ln_stats_agent(float* st, int r, float& mu, float& rstd) {
    const float s = __hip_atomic_load(st + 2 * r, __ATOMIC_RELAXED, __HIP_MEMORY_SCOPE_AGENT), q = __hip_atomic_load(st + 2 * r + 1, __ATOMIC_RELAXED, __HIP_MEMORY_SCOPE_AGENT);
    mu = s * (1.0f / DM); const float var = q * (1.0f / DM) - mu * mu; rstd = rsqrtf(var + LN_EPS);
}
struct EpiDownF {
    static constexpr bool GU = false, STATS = true, AFTER_DRAIN = true;
    const bf16_t* pb16; const float* st1; const float* g1; const float* b1; float* st2; float* yo; const float* g2; const float* b2; unsigned* cnt;
    struct Row { float mu, rstd; };
    __device__ __forceinline__ Row row_begin(int r) const { Row R; ln_stats(st1, r, R.mu, R.rstd); return R; }
    __device__ __forceinline__ f32x4 load(const Row&, int r, int c) const { return up4(*(const u32x2*)(pb16 + (size_t)r * DM + c)); }
    __device__ __forceinline__ f32x4 pre2(const Row& R, int c, f32x4 v, f32x4 pv, float& s, float& q) const {
        const f32x4 gv = *(const f32x4*)(g1 + c), bv = *(const f32x4*)(b1 + c);
        const f32x4 x1 = (pv - R.mu) * R.rstd * gv + bv;
        const f32x4 o = x1 * ALPHA + v;
        s += (o[0] + o[1]) + (o[2] + o[3]);
        q += (o[0] * o[0] + o[1] * o[1]) + (o[2] * o[2] + o[3] * o[3]);
        return o;
    }
    __device__ __forceinline__ void vec(const Row& R, int r, int c, f32x4 v, f32x4 pv, float& s, float& q) const { *(f32x4*)(yo + (size_t)r * DM + c) = pre2(R, c, v, pv, s, q); }
    __device__ __forceinline__ void row_end(int r, float s, float q) const { atomicAdd(st2 + 2 * r, s); atomicAdd(st2 + 2 * r + 1, q); }
    __device__ __forceinline__ void fused(f32x4 (&acc)[2][2][4][2], const Unit& u, int wr, int wc, int fr, int fq) const {
        const int rbase = u.pm * 256 + wr * 64 + fr, cbase = u.pn * 256 + wc * 32 + 4 * fq;
        {
            Row Rn = row_begin(rbase);
            f32x4 inn[4];
#pragma unroll
            for (int j = 0; j < 4; ++j) inn[j] = load(Rn, rbase, cbase + (j >> 1) * 128 + (j & 1) * 16);
#pragma unroll
            for (int g = 0; g < 8; ++g) {
                const int ai = g >> 2, m = g & 3, r = rbase + ai * 128 + m * 16;
                const Row R = Rn;
                f32x4 in[4];
#pragma unroll
                for (int j = 0; j < 4; ++j) in[j] = inn[j];
                if (g < 7) {
                    const int r2 = rbase + ((g + 1) >> 2) * 128 + ((g + 1) & 3) * 16;
                    Rn = row_begin(r2);
#pragma unroll
                    for (int j = 0; j < 4; ++j) inn[j] = load(Rn, r2, cbase + (j >> 1) * 128 + (j & 1) * 16);
                }
                float s = 0.f, q = 0.f;
#pragma unroll
                for (int j = 0; j < 4; ++j) acc[ai][j >> 1][m][j & 1] = pre2(R, cbase + (j >> 1) * 128 + (j & 1) * 16, acc[ai][j >> 1][m][j & 1], in[j], s, q);
                s += __shfl_xor(s, 16); s += __shfl_xor(s, 32);
                q += __shfl_xor(q, 16); q += __shfl_xor(q, 32);
                if (fq == 0) row_end(r, s, q);
            }
        }
        panel_meet(cnt + 64 * u.pm, 4u);
        f32x4 gv[4], bv[4];
#pragma unroll
        for (int j = 0; j < 4; ++j) { const int c = cbase + (j >> 1) * 128 + (j & 1) * 16; gv[j] = *(const f32x4*)(g2 + c); bv[j] = *(const f32x4*)(b2 + c); }
        float mu8[8], rs8[8];
#pragma unroll
        for (int g = 0; g < 8; ++g) ln_stats_agent(st2, rbase + (g >> 2) * 128 + (g & 3) * 16, mu8[g], rs8[g]);
#pragma unroll
        for (int g = 0; g < 8; ++g) {
            const int ai = g >> 2, m = g & 3, r = rbase + ai * 128 + m * 16;
            const float mu = mu8[g], rstd = rs8[g];
#pragma unroll
            for (int j = 0; j < 4; ++j) __builtin_nontemporal_store((acc[ai][j >> 1][m][j & 1] - mu) * rstd * gv[j] + bv[j], (f32x4*)(yo + (size_t)r * DM + cbase + (j >> 1) * 128 + (j & 1) * 16));
        }
    }
    __device__ __forceinline__ void fused_mini(f32x4 (&acc)[2], int r, int rowblk, int c0, int fq) const {
        const Row R = row_begin(r);
        float s = 0.f, q = 0.f;
#pragma unroll
        for (int nb = 0; nb < 2; ++nb) acc[nb] = pre2(R, c0 + nb * 32, acc[nb], load(R, r, c0 + nb * 32), s, q);
        s += __shfl_xor(s, 16); s += __shfl_xor(s, 32);
        q += __shfl_xor(q, 16); q += __shfl_xor(q, 32);
        if (fq == 0) row_end(r, s, q);
        panel_meet(cnt + 64 * (64 + rowblk), 16u);
        float mu, rstd; ln_stats_agent(st2, r, mu, rstd);
#pragma unroll
        for (int nb = 0; nb < 2; ++nb) { const int c = c0 + nb * 32; *(f32x4*)(yo + (size_t)r * DM + c) = (acc[nb] - mu) * rstd * *(const f32x4*)(g2 + c) + *(const f32x4*)(b2 + c); }
    }
};

template <class Epi>
__device__ __forceinline__ void epi_main(const Epi& E, const f32x4 (&acc)[2][2][4][2], const Unit& u, int wr, int wc, int fr, int fq) {
    const int rbase = u.pm * 256 + wr * 64 + fr;
    if constexpr (Epi::GU) {
        f32x4 csg[2], csu[2], bwg[2], bwu[2];
#pragma unroll
        for (int n = 0; n < 2; ++n) {
            const int cgi = u.pn * 256 + wc * 32 + n * 16 + 4 * fq;
            csg[n] = *(const f32x4*)(E.cs + cgi); csu[n] = *(const f32x4*)(E.cs + cgi + 128);
            bwg[n] = *(const f32x4*)(E.bw + cgi); bwu[n] = *(const f32x4*)(E.bw + cgi + 128);
        }
        typename Epi::Row Rn = E.row_begin(rbase);
#pragma unroll
        for (int g = 0; g < 8; ++g) {
            const int ai = g >> 2, m = g & 3, r = rbase + ai * 128 + m * 16;
            const typename Epi::Row R = Rn;
            if (g < 7) Rn = E.row_begin(rbase + ((g + 1) >> 2) * 128 + ((g + 1) & 3) * 16);
#pragma unroll
            for (int n = 0; n < 2; ++n) E.vec2c(R, r, u.pn * 128 + wc * 32 + n * 16 + 4 * fq, acc[ai][0][m][n], acc[ai][1][m][n], csg[n], csu[n], bwg[n], bwu[n]);
        }
    } else {
        const int cbase = u.pn * 256 + wc * 32 + 4 * fq;
        typename Epi::Row Rn = E.row_begin(rbase);
        f32x4 inn[4];
#pragma unroll
        for (int j = 0; j < 4; ++j) inn[j] = E.load(Rn, rbase, cbase + (j >> 1) * 128 + (j & 1) * 16);
#pragma unroll
        for (int g = 0; g < 8; ++g) {
            const int ai = g >> 2, m = g & 3, r = rbase + ai * 128 + m * 16;
            const typename Epi::Row R = Rn;
            f32x4 in[4];
#pragma unroll
            for (int j = 0; j < 4; ++j) in[j] = inn[j];
            if (g < 7) {
                const int r2 = rbase + ((g + 1) >> 2) * 128 + ((g + 1) & 3) * 16;
                Rn = E.row_begin(r2);
#pragma unroll
                for (int j = 0; j < 4; ++j) inn[j] = E.load(Rn, r2, cbase + (j >> 1) * 128 + (j & 1) * 16);
            }
            float s = 0.f, q = 0.f;
#pragma unroll
            for (int j = 0; j < 4; ++j) E.vec(R, r, cbase + (j >> 1) * 128 + (j & 1) * 16, acc[ai][j >> 1][m][j & 1], in[j], s, q);
            if constexpr (Epi::STATS) {
                s += __shfl_xor(s, 16); s += __shfl_xor(s, 32);
                q += __shfl_xor(q, 16); q += __shfl_xor(q, 32);
                if (fq == 0) E.row_end(r, s, q);
            }
        }
    }
}

template <class Epi>
__device__ __forceinline__ void mini_gemm_tile(LAS unsigned char* lds, const bf16_t* __restrict__ A, const bf16_t* __restrict__ Bt, int K, int m0, int nt_idx, const Epi& E) {
    constexpr int LDT = 136;
    LAS bf16_t* As = (LAS bf16_t*)lds;
    LAS bf16_t* Bs = As + 2 * 64 * LDT;
    const int tid = threadIdx.x, lane = tid & 63, wave = tid >> 6, wr = wave >> 1, wc = wave & 1, fr = lane & 15, fq = lane >> 4;
    const int lrow = tid >> 3, lcol = (tid & 7) * 8;
    int brow;
    if constexpr (Epi::GU) brow = (nt_idx >> 2) * 256 + (lrow >> 5) * 128 + (nt_idx & 3) * 32 + (lrow & 31); else brow = nt_idx * 64 + lrow;
    const bf16_t* ap = A + (size_t)(m0 + lrow) * K + lcol;
    const bf16_t* bp = Bt + (size_t)brow * K + lcol;
    u32x4 ra[4], rb[4], rc[4], rd[4];
#define MG_LOAD(r, kt) do { r[0] = *(const u32x4*)(ap + (kt) * 128); r[1] = *(const u32x4*)(ap + (kt) * 128 + 64); r[2] = *(const u32x4*)(bp + (kt) * 128); r[3] = *(const u32x4*)(bp + (kt) * 128 + 64); } while (0)
#define MG_STORE(r, buf) do { *(LAS u32x4*)(As + ((buf) * 64 + lrow) * LDT + lcol) = r[0]; *(LAS u32x4*)(As + ((buf) * 64 + lrow) * LDT + lcol + 64) = r[1]; \
                              *(LAS u32x4*)(Bs + ((buf) * 64 + lrow) * LDT + lcol) = r[2]; *(LAS u32x4*)(Bs + ((buf) * 64 + lrow) * LDT + lcol + 64) = r[3]; } while (0)
#define MG_COMPUTE(buf) do { _Pragma("unroll") for (int ks = 0; ks < 4; ++ks) { \
        const bf16x8 af = *(const LAS bf16x8*)(As + ((buf) * 64 + wr * 16 + fr) * LDT + ks * 32 + fq * 8); \
        _Pragma("unroll") for (int nb = 0; nb < 2; ++nb) { const bf16x8 bfr = *(const LAS bf16x8*)(Bs + ((buf) * 64 + nb * 32 + wc * 16 + fr) * LDT + ks * 32 + fq * 8); \
            acc[nb] = __builtin_amdgcn_mfma_f32_16x16x32_bf16(bfr, af, acc[nb], 0, 0, 0); } } } while (0)
#define MG_STEP(r, kt_, buf) do { MG_STORE(r, buf); __syncthreads(); if ((kt_) + 4 < nkt) MG_LOAD(r, (kt_) + 4); MG_COMPUTE(buf); } while (0)
    f32x4 acc[2] = {(f32x4){0.f, 0.f, 0.f, 0.f}, (f32x4){0.f, 0.f, 0.f, 0.f}};
    const int nkt = K / 128;
    MG_LOAD(ra, 0); MG_LOAD(rb, 1); MG_LOAD(rc, 2); MG_LOAD(rd, 3);
    int kt = 0;
    for (; kt + 4 <= nkt; kt += 4) { MG_STEP(ra, kt, 0); MG_STEP(rb, kt + 1, 1); MG_STEP(rc, kt + 2, 0); MG_STEP(rd, kt + 3, 1); }
    if (kt < nkt) { MG_STEP(ra, kt, 0); MG_STEP(rb, kt + 1, 1); }
    __syncthreads();
#undef MG_STEP
#undef MG_LOAD
#undef MG_STORE
#undef MG_COMPUTE
    const int r = m0 + wr * 16 + fr;
    if constexpr (Epi::AFTER_DRAIN) { E.fused_mini(acc, r, (m0 - MP) >> 6, nt_idx * 64 + wc * 16 + 4 * fq, fq); return; }
    const typename Epi::Row R = E.row_begin(r);
    if constexpr (Epi::GU) {
        const int pn = nt_idx >> 2, ffo = (nt_idx & 3) * 32;
        E.vec2(R, r, pn * 128 + ffo + wc * 16 + 4 * fq, pn * 256 + ffo + wc * 16 + 4 * fq, acc[0], acc[1]);
    } else {
        float s = 0.f, q = 0.f;
#pragma unroll
        for (int nb = 0; nb < 2; ++nb) { const int c = nt_idx * 64 + nb * 32 + wc * 16 + 4 * fq; E.vec(R, r, c, acc[nb], E.load(R, r, c), s, q); }
        if constexpr (Epi::STATS) {
            s += __shfl_xor(s, 16); s += __shfl_xor(s, 32);
            q += __shfl_xor(q, 16); q += __shfl_xor(q, 32);
            if (fq == 0) E.row_end(r, s, q);
        }
    }
}
template <class Epi>
__device__ __forceinline__ void mini_gemm_phase(LAS unsigned char* lds, const bf16_t* A, const bf16_t* Bt, int K, int ntiles_n, int wg0, int nwg, const Epi& E) {
    const int me = (int)blockIdx.x - wg0;
    if (me < 0 || me >= nwg) return;
    for (int it = me; it < 4 * ntiles_n; it += nwg) mini_gemm_tile(lds, A, Bt, K, MP + (it & 3) * 64, it >> 2, E);
}

__device__ __forceinline__ void transpose_item(const float* __restrict__ src, int K, int N, int n0, bf16_t* __restrict__ dst, int ldd,
                                               const float* __restrict__ gs, const float* __restrict__ bv, float* cs_out, float* bw_out, LAS float* tile) {
    const int tid = threadIdx.x, ln = tid & 63, lr = tid >> 6;
    const int nt = K / 64;
    float cur[8], nxt[8];
#pragma unroll
    for (int i = 0; i < 8; ++i) cur[i] = src[(size_t)(lr + 8 * i) * N + n0 + ln];
    float csp = 0.f, bwp = 0.f;
    for (int t = 0; t < nt; ++t) {
        if (t + 1 < nt) {
#pragma unroll
            for (int i = 0; i < 8; ++i) nxt[i] = src[(size_t)((t + 1) * 64 + lr + 8 * i) * N + n0 + ln];
        }
        LAS float* tl = tile + (t & 1) * (64 * 65);
#pragma unroll
        for (int i = 0; i < 8; ++i) {
            const int k = t * 64 + lr + 8 * i;
            const float g = gs ? gs[k] : 1.0f; const float b = bv ? bv[k] : 0.0f;
            const float w = bf2f(f2bf(cur[i] * g));
            csp += w; bwp += b * cur[i];
            tl[(lr + 8 * i) * 65 + ln] = w;
        }
        __syncthreads();
#pragma unroll
        for (int i = 0; i < 8; ++i) {
            const int n = lr + 8 * i;
            dst[(size_t)n * ldd + t * 64 + ln] = f2bf(tl[ln * 65 + n]);
        }
#pragma unroll
        for (int i = 0; i < 8; ++i) cur[i] = nxt[i];
    }
    __syncthreads();
    if (cs_out) {
        LAS float* red = tile;
        red[lr * 64 + ln] = csp; red[512 + lr * 64 + ln] = bwp;
        __syncthreads();
        if (tid < 64) {
            float a = 0.f, b = 0.f;
#pragma unroll
            for (int i = 0; i < 8; ++i) { a += red[i * 64 + tid]; b += red[512 + i * 64 + tid]; }
            cs_out[tid] = a; bw_out[tid] = b;
        }
        __syncthreads();
    }
}

__device__ void phase0(const Params& p, LAS unsigned char* lds) {
    const int tid = threadIdx.x, nb = gridDim.x, bid = blockIdx.x;
    LAS float* tile = (LAS float*)lds;
    bf16_t* WinT = (bf16_t*)(p.ws + WS_WIN); bf16_t* WoutT = (bf16_t*)(p.ws + WS_WOUT); bf16_t* WguT = (bf16_t*)(p.ws + WS_WGU); bf16_t* WdT = (bf16_t*)(p.ws + WS_WD);
    bf16_t* pwT = (bf16_t*)(p.ws + WS_PWT); float* cs = (float*)(p.ws + WS_CS); float* bw = (float*)(p.ws + WS_BW);
    for (int item = bid; item < 160; item += nb) {
        if (item < 32) { const int n0 = item * 64; transpose_item(p.w_in, DM, NIN, n0, WinT + (size_t)n0 * DM, DM, nullptr, nullptr, nullptr, nullptr, tile); }
        else if (item < 48) { const int n0 = (item - 32) * 64; transpose_item(p.w_out, DM, DM, n0, WoutT + (size_t)n0 * DM, DM, nullptr, nullptr, nullptr, nullptr, tile); }
        else if (item < 136) {
            const int isu = item >= 92; const int n0 = (item - (isu ? 92 : 48)) * 64;
            const int drow = (n0 >> 7) * 256 + isu * 128 + (n0 & 127);
            transpose_item(isu ? p.wu : p.wg, DM, DFF, n0, WguT + (size_t)drow * DM, DM, p.ln1g, p.ln1b, cs + drow, bw + drow, tile);
        }
        else if (item < 152) { const int n0 = (item - 136) * 64; transpose_item(p.wd, DFF, DM, n0, WdT + (size_t)n0 * DFF, DFF, nullptr, nullptr, nullptr, nullptr, tile); }
        else { const int j = item - 152, g = j >> 1, n0 = (j & 1) * 64; transpose_item(p.pool_w + (size_t)g * 16384, 128, 128, n0, pwT + (size_t)g * 16384 + (size_t)n0 * 128, 128, nullptr, nullptr, nullptr, nullptr, tile); }
    }
    {
        bf16_t* xb = (bf16_t*)(p.ws + WS_A);
        const size_t n8 = (size_t)MT * DM / 8, np8 = (size_t)MP * DM / 8;
        for (size_t i = (size_t)bid * 512 + tid; i < n8; i += (size_t)nb * 512) {
            const f32x4* s = (i < np8) ? (const f32x4*)p.xp + 2 * i : (const f32x4*)p.xs + 2 * (i - np8);
            const f32x4 a = __builtin_nontemporal_load(s), b = __builtin_nontemporal_load(s + 1);
            u32x4 o; o.x = pk_bf16(a[0], a[1]); o.y = pk_bf16(a[2], a[3]); o.z = pk_bf16(b[0], b[1]); o.w = pk_bf16(b[2], b[3]);
            ((u32x4*)xb)[i] = o;
        }
    }
    {
        float* st = (float*)(p.ws + WS_ST1);
        for (int i = bid * 512 + tid; i < MT * 4; i += nb * 512) st[i] = 0.f;
    }
}

__device__ __forceinline__ float softplus2_f(float z2) { return fmaxf(z2, 0.f) + __builtin_amdgcn_logf(1.0f + __builtin_amdgcn_exp2f(-fabsf(z2))); }

__device__ __forceinline__ void attn_tile_t(const bf16x8 (&Kf)[2][2], const bf16x8 (&Qf)[2][2], LAS unsigned short* vt, f32x4 (&O)[2][4], float (&R)[2], bool DIAG, int c16, int g) {
    bf16x8 Vf[4];
#pragma unroll
    for (int db = 0; db < 4; ++db) {
        const u32x2 lo = *(const LAS u32x2*)(vt + (db * 16 + c16) * 36 + (db >> 1) * 4 + g * 4);
        const u32x2 hi = *(const LAS u32x2*)(vt + (db * 16 + c16) * 36 + (db >> 1) * 4 + 16 + g * 4);
        u32x4 o; o.x = lo.x; o.y = lo.y; o.z = hi.x; o.w = hi.y;
        Vf[db] = __builtin_bit_cast(bf16x8, o);
    }
#pragma unroll
    for (int qb = 0; qb < 2; ++qb) {
        f32x4 z[2];
#pragma unroll
        for (int kb = 0; kb < 2; ++kb) {
            z[kb] = __builtin_amdgcn_mfma_f32_16x16x32_bf16(Kf[kb][0], Qf[qb][0], (f32x4){0.f, 0.f, 0.f, 0.f}, 0, 0, 0);
            z[kb] = __builtin_amdgcn_mfma_f32_16x16x32_bf16(Kf[kb][1], Qf[qb][1], z[kb], 0, 0, 0);
        }
        float sp[2][4], lb[2][4]; bool ok[2][4];
        const int qrel = qb * 16 + c16;
#pragma unroll
        for (int kb = 0; kb < 2; ++kb)
#pragma unroll
            for (int j = 0; j < 4; ++j) {
                const int krel = kb * 16 + g * 4 + j;
                ok[kb][j] = (!DIAG) || (krel < qrel);
                const float zz = z[kb][j]; const float sf = softplus2_f(zz);
                sp[kb][j] = ok[kb][j] ? sf : 0.f; lb[kb][j] = zz - sf;
            }
        float ex[2][4], tot[2], hg[2], bt[2];
#pragma unroll
        for (int kb = 0; kb < 2; ++kb) {
            ex[kb][3] = 0.f; ex[kb][2] = sp[kb][3]; ex[kb][1] = ex[kb][2] + sp[kb][2]; ex[kb][0] = ex[kb][1] + sp[kb][1];
            tot[kb] = ex[kb][0] + sp[kb][0];
            const float a1 = __shfl_xor(tot[kb], 16), a2 = __shfl_xor(tot[kb], 32), a3 = __shfl_xor(tot[kb], 48);
            hg[kb] = (g == 0) ? (a1 + a2 + a3) : (g == 1) ? (a2 + a3) : (g == 2) ? a1 : 0.f;
            bt[kb] = (tot[kb] + a1) + (a2 + a3);
        }
        float pr[2][4];
#pragma unroll
        for (int j = 0; j < 4; ++j) {
            const float af1 = R[qb] + hg[1] + ex[1][j];
            const float af0 = R[qb] + bt[1] + hg[0] + ex[0][j];
            pr[1][j] = ok[1][j] ? __builtin_amdgcn_exp2f(lb[1][j] - af1) : 0.f;
            pr[0][j] = ok[0][j] ? __builtin_amdgcn_exp2f(lb[0][j] - af0) : 0.f;
        }
        R[qb] += bt[0] + bt[1];
        u32x4 po; po.x = pk_bf16(pr[0][0], pr[0][1]); po.y = pk_bf16(pr[0][2], pr[0][3]); po.z = pk_bf16(pr[1][0], pr[1][1]); po.w = pk_bf16(pr[1][2], pr[1][3]);
        const bf16x8 Pf = __builtin_bit_cast(bf16x8, po);
#pragma unroll
        for (int db = 0; db < 4; ++db) O[qb][db] = __builtin_amdgcn_mfma_f32_16x16x32_bf16(Vf[db], Pf, O[qb][db], 0, 0, 0);
    }
}
__device__ __forceinline__ void attn_tile(const bf16x8 (&Kf)[2][2], const bf16x8 (&Qf)[2][2], LAS unsigned short* vt, f32x4 (&O)[2][4], float (&R)[2], bool diag, int c16, int g) {
    attn_tile_t(Kf, Qf, vt, O, R, diag, c16, g);
}
#define WAVE_LDS_SYNC() do { asm volatile("" ::: "memory"); __builtin_amdgcn_wave_barrier(); asm volatile("" ::: "memory"); } while (0)

__device__ __forceinline__ void attn_item(const Params& p, int item, const bf16_t* __restrict__ qkvb, bf16_t* __restrict__ concat, LAS unsigned short* vt, int lane) {
    const bool prompt = item < 4096;
    int b, h, qt;
    if (prompt) { qt = item & 127; h = (item >> 7) & 7; b = item >> 10; } else { const int s = item - 4096; h = s & 7; b = s >> 3; qt = 0; }
    const size_t rowq = (prompt ? (size_t)b * SEQ : (size_t)MP + b * DSEQ) + qt * 32;
    const int qpos0 = (prompt ? 0 : PAST) + qt * 32;
    const int c16 = lane & 15, g = lane >> 4;
    bf16x8 Qf[2][2];
#pragma unroll
    for (int qb = 0; qb < 2; ++qb)
#pragma unroll
        for (int dh = 0; dh < 2; ++dh) Qf[qb][dh] = *(const bf16x8*)(qkvb + (rowq + qb * 16 + c16) * 1536 + h * 64 + dh * 32 + g * 8);
    f32x4 O[2][4];
#pragma unroll
    for (int qb = 0; qb < 2; ++qb)
#pragma unroll
        for (int db = 0; db < 4; ++db) O[qb][db] = (f32x4){0.f, 0.f, 0.f, 0.f};
    float R[2] = {0.f, 0.f};
    const int key = lane >> 1, dhalf = (lane & 1) * 32;
    {
        for (int kt = qpos0 >> 5; kt >= 0; --kt) {
            const int kp0 = kt << 5;
            bf16x8 Kf[2][2];
            if (prompt || kp0 >= PAST) {
                const size_t krow = prompt ? (size_t)b * SEQ + kp0 : (size_t)MP + b * DSEQ + (kp0 - PAST);
#pragma unroll
                for (int kb = 0; kb < 2; ++kb)
#pragma unroll
                    for (int dh = 0; dh < 2; ++dh) Kf[kb][dh] = *(const bf16x8*)(qkvb + (krow + kb * 16 + c16) * 1536 + 512 + h * 64 + dh * 32 + g * 8);
                const bf16_t* vp = qkvb + (krow + key) * 1536 + 1024 + h * 64 + dhalf;
#pragma unroll
                for (int i = 0; i < 4; ++i) {
                    const bf16x8 v = *(const bf16x8*)(vp + i * 8);
#pragma unroll
                    for (int e = 0; e < 8; ++e) vt[(dhalf + i * 8 + e) * 36 + (dhalf >> 3) + key] = (unsigned short)v[e];
                }
            } else {
                const float* kp = p.ck + ((size_t)(b * PAST + kp0) * 8 + h) * 64;
#pragma unroll
                for (int kb = 0; kb < 2; ++kb)
#pragma unroll
                    for (int dh = 0; dh < 2; ++dh) {
                        const float* sp_ = kp + (size_t)(kb * 16 + c16) * 512 + dh * 32 + g * 8;
                        const f32x4 a = *(const f32x4*)sp_, bb = *(const f32x4*)(sp_ + 4);
                        u32x4 o; o.x = pk_bf16(a[0], a[1]); o.y = pk_bf16(a[2], a[3]); o.z = pk_bf16(bb[0], bb[1]); o.w = pk_bf16(bb[2], bb[3]);
                        Kf[kb][dh] = __builtin_bit_cast(bf16x8, o);
                    }
                const float* vp = p.cv + ((size_t)(b * PAST + kp0 + key) * 8 + h) * 64 + dhalf;
#pragma unroll
                for (int i = 0; i < 8; ++i) {
                    const f32x4 v = *(const f32x4*)(vp + i * 4);
#pragma unroll
                    for (int e = 0; e < 4; ++e) vt[(dhalf + i * 4 + e) * 36 + (dhalf >> 3) + key] = f2bf(v[e]);
                }
            }
            WAVE_LDS_SYNC();
            attn_tile(Kf, Qf, vt, O, R, kp0 == qpos0, c16, g);
            WAVE_LDS_SYNC();
            if (__all(fminf(R[0], R[1]) > R_EXIT)) break;
        }
    }
#pragma unroll
    for (int qb = 0; qb < 2; ++qb)
#pragma unroll
        for (int db = 0; db < 4; ++db)
            *(u32x2*)(concat + (rowq + qb * 16 + c16) * DM + h * 64 + db * 16 + g * 4) = pk4(O[qb][db]);
}

template <int G>
__device__ __forceinline__ void pool_item_g(const Params& p, int tokblk, const bf16_t* __restrict__ ubuf, const bf16_t* __restrict__ pwT, bf16_t* __restrict__ concat, LAS bf16_t* dt, int lane) {
    constexpr int W = 2 << G;
    const int r0 = tokblk * 16;
    int t0, start; size_t rb; const float* hist;
    if (r0 < MP) { t0 = r0 & (SEQ - 1); rb = (size_t)(r0 - t0); start = 0; hist = nullptr; }
    else { const int rr = r0 - MP; const int b = rr >> 5; t0 = rr & 31; rb = (size_t)MP + b * DSEQ; start = PAST; hist = p.sp + (size_t)b * 15 * 512; }
    const int c16 = lane & 15, gq = lane >> 4;
    const bf16_t* wbase = pwT + (size_t)G * 16384 + (size_t)c16 * 128 + gq * 8;
    float v[2][15 + W];
#pragma unroll
    for (int half = 0; half < 2; ++half) {
        const int ch = G * 128 + half * 64 + lane;
#pragma unroll
        for (int i = 0; i < 15 + W; ++i) {
            const int t = t0 - (W - 1) + i;
            const int tc = (t >= 0) ? t : 0;
            const float xu = bf2f(ubuf[(rb + tc) * 512 + ch]);
            const float xh = (t < 0 && hist) ? hist[(size_t)(15 + t) * 512 + ch] : 0.f;
            v[half][i] = (t >= 0) ? xu : xh;
        }
    }
#pragma unroll
    for (int half = 0; half < 2; ++half) {
        float s = 0.f;
#pragma unroll
        for (int i = 0; i < W - 1; ++i) s += v[half][i];
#pragma unroll
        for (int i = 0; i < 16; ++i) {
            const float cur = v[half][W - 1 + i];
            s += cur;
            const int cnt = min(W, start + t0 + i + 1);
            const float d = s / (float)cnt - cur;
            dt[i * 136 + half * 64 + lane] = f2bf(d);
            s -= v[half][i];
        }
    }
    WAVE_LDS_SYNC();
    f32x4 acc[8];
    bf16x8 bfrag[4];
#pragma unroll
    for (int ks = 0; ks < 4; ++ks) bfrag[ks] = *(const LAS bf16x8*)(dt + c16 * 136 + ks * 32 + gq * 8);
    const bf16_t* wp = wbase;
    asm volatile("" : "+v"(wp));
    bf16x8 wa[8][4];
#pragma unroll
    for (int nb = 0; nb < 8; ++nb)
#pragma unroll
        for (int ks = 0; ks < 4; ++ks) wa[nb][ks] = *(const bf16x8*)(wp + (size_t)nb * 16 * 128 + ks * 32);
    asm volatile("" ::: "memory");
#pragma unroll
    for (int nb = 0; nb < 8; ++nb) {
        acc[nb] = (f32x4){0.f, 0.f, 0.f, 0.f};
#pragma unroll
        for (int ks = 0; ks < 4; ++ks) acc[nb] = __builtin_amdgcn_mfma_f32_16x16x32_bf16(wa[nb][ks], bfrag[ks], acc[nb], 0, 0, 0);
    }
    const int row = r0 + c16;
#pragma unroll
    for (int nb = 0; nb < 8; ++nb) {
        const int dout = G * 128 + nb * 16 + gq * 4;
        const f32x4 sc = *(const f32x4*)(p.pool_scale + dout);
        *(u32x2*)(concat + (size_t)row * DM + 512 + dout) = pk4(acc[nb] * sc);
    }
    WAVE_LDS_SYNC();
}

constexpr int P2_ITEMS = 8320, P2_PER_Q = P2_ITEMS / 8;
__device__ __forceinline__ void phase2(const Params& p, LAS unsigned char* lds, const bf16_t* qkvb, const bf16_t* ubuf, bf16_t* concat) {
    const int tid = threadIdx.x, wave = tid >> 6, lane = tid & 63;
    LAS unsigned short* wl = (LAS unsigned short*)(lds + wave * 4864);
    unsigned* ctr = (unsigned*)(p.ws + WS_BAR + 14336);
    const bf16_t* pwT = (const bf16_t*)(p.ws + WS_PWT);
    const int q0 = blockIdx.x & 7;
    for (int qq = 0; qq < 8; ++qq) {
        const int qi = (q0 + qq) & 7;
        for (;;) {
            unsigned i = 0;
            if (lane == 0) i = __hip_atomic_fetch_add(ctr + qi * 64, 1u, __ATOMIC_RELAXED, __HIP_MEMORY_SCOPE_AGENT);
            i = (unsigned)__builtin_amdgcn_readfirstlane((int)i);
            if (i >= (unsigned)P2_PER_Q) break;
            const int j = (int)i >> 1;
            const int item = ((int)i & 1) ? 4160 + qi * 520 + j : (j < 8 ? 4096 + qi * 8 + j : qi * 512 + (j - 8));
            if (item < 4160) attn_item(p, item, qkvb, concat, wl, lane);
            else {
                const int j = item - 4160, tokblk = j >> 2, g = j & 3;
                LAS bf16_t* dt = (LAS bf16_t*)wl;
                if (g == 0) pool_item_g<0>(p, tokblk, ubuf, pwT, concat, dt, lane);
                else if (g == 1) pool_item_g<1>(p, tokblk, ubuf, pwT, concat, dt, lane);
                else if (g == 2) pool_item_g<2>(p, tokblk, ubuf, pwT, concat, dt, lane);
                else pool_item_g<3>(p, tokblk, ubuf, pwT, concat, dt, lane);
            }
        }
    }
    (void)ctr;
}

__global__ void __launch_bounds__(512, 2) fwd_megakernel(Params p) {
    __shared__ __attribute__((aligned(16))) unsigned char smem[pg8::STAGE_BYTES];
    LAS unsigned char* lds = (LAS unsigned char*)smem;
    cg::grid_group grid = cg::this_grid();
    __shared__ uint4 xb_words;
    if (threadIdx.x == 0) xb_words = make_uint4(0u, 0u, 0u, 0u);
    __syncthreads();
    const XcdBarrier gbar = xcd_barrier_post((unsigned*)(p.ws + WS_BAR), (volatile LAS unsigned*)&xb_words);
    const int tid = threadIdx.x, bid = blockIdx.x, nb = gridDim.x;
    bf16_t* xb = (bf16_t*)(p.ws + WS_A); bf16_t* hid = (bf16_t*)(p.ws + WS_A);
    bf16_t* qkvb = (bf16_t*)(p.ws + WS_B); bf16_t* pb16 = (bf16_t*)(p.ws + WS_B); bf16_t* ubuf = (bf16_t*)(p.ws + WS_UB);
    bf16_t* concat = (bf16_t*)(p.ws + WS_C);
    float* st1 = (float*)(p.ws + WS_ST1); float* st2 = (float*)(p.ws + WS_ST2);
#ifndef PHMASK
#define PHMASK 127
#endif
#ifndef REPMASK
#define REPMASK 0
#endif
#ifndef REPBAR
#define REPBAR 0
#endif
#define PH_RUN(k, lam) if ((PHMASK & (1 << (k))) && p.ph_lo <= (k) && (k) < p.ph_hi) { if ((k) > p.ph_lo) { if (p.ph_lo < 0) grid.sync(); else xcd_barrier(gbar); } \
        if ((REPMASK >> (k)) & 1) { lam(true); if (REPBAR) xcd_barrier(gbar); else __syncthreads(); } lam(false); }
    float* const dummy_st = (float*)(p.ws + WS_END);
    float* const scratch_y = (float*)(p.ws + WS_B + (size_t)MT * DM * 2);
    auto ph0 = [&](bool) { phase0(p, lds); };
    auto ph1 = [&](bool) {
        pg8::StaticOrder S; S.init(MP, NIN, nb, bid);
        EpiIn E{qkvb, ubuf, p.out};
        pg8::gemm_phase(lds, pg8::Gemm{xb, (const bf16_t*)(p.ws + WS_WIN), MP, NIN, DM}, S, E);
        mini_gemm_phase(lds, xb, (const bf16_t*)(p.ws + WS_WIN), DM, NIN / 64, 0, nb < 128 ? nb : 128, E);
    };
    auto ph2 = [&](bool) { phase2(p, lds, qkvb, ubuf, concat); };
    auto ph3 = [&](bool probe) {
        pg8::StaticOrder S; S.init(MP, DM, nb, bid);
        EpiOut E{xb, pb16, probe ? dummy_st : st1};
        pg8::gemm_phase(lds, pg8::Gemm{concat, (const bf16_t*)(p.ws + WS_WOUT), MP, DM, DM}, S, E);
        mini_gemm_phase(lds, concat, (const bf16_t*)(p.ws + WS_WOUT), DM, DM / 64, 0, nb < 64 ? nb : 64, E);
    };
    auto ph4 = [&](bool) {
        pg8::StaticOrder S; S.init(MP, NGU, nb, bid);
        EpiGU E{st1, (const float*)(p.ws + WS_CS), (const float*)(p.ws + WS_BW), hid};
        pg8::gemm_phase(lds, pg8::Gemm{pb16, (const bf16_t*)(p.ws + WS_WGU), MP, NGU, DM}, S, E);
        mini_gemm_phase(lds, pb16, (const bf16_t*)(p.ws + WS_WGU), DM, DFF / 32, nb == 256 ? 128 : 0, nb == 256 ? 128 : nb, E);
    };
    const bool fuse_ln2 = (nb == MP / 256 * (DM / 256)) && !((REPMASK >> 5) & 1);
    auto ph5f = [&](bool) {
        pg8::StaticOrder S; S.init(MP, DM, nb, bid);
        EpiDownF E{pb16, st1, p.ln1g, p.ln1b, st2, p.out + OFF_YP, p.ln2g, p.ln2b, (unsigned*)(p.ws + WS_BAR + 16384)};
        pg8::gemm_phase(lds, pg8::Gemm{hid, (const bf16_t*)(p.ws + WS_WD), MP, DM, DFF}, S, E);
        mini_gemm_phase(lds, hid, (const bf16_t*)(p.ws + WS_WD), DFF, DM / 64, 0, 64, E);
    };
    auto ph5 = [&](bool probe) {
        if (fuse_ln2) { ph5f(probe); return; }
        pg8::StaticOrder S; S.init(MP, DM, nb, bid);
        EpiDown E{pb16, st1, p.ln1g, p.ln1b, probe ? dummy_st : st2, probe ? scratch_y : p.out + OFF_YP};
        pg8::gemm_phase(lds, pg8::Gemm{hid, (const bf16_t*)(p.ws + WS_WD), MP, DM, DFF}, S, E);
        mini_gemm_phase(lds, hid, (const bf16_t*)(p.ws + WS_WD), DFF, DM / 64, 0, nb < 64 ? nb : 64, E);
    };
    auto ph6 = [&](bool probe) {
        f32x4* y4 = (f32x4*)(p.out + OFF_YP);
        f32x4* yo4 = probe ? (f32x4*)scratch_y : y4;
        const size_t n4 = (size_t)MT * DM / 4;
        for (size_t i = (size_t)bid * 512 + tid; i < n4; i += (size_t)nb * 512) {
            const int r = (int)(i >> 8), c4 = (int)(i & 255);
            const float s = st2[2 * r], q = st2[2 * r + 1];
            const float mu = s * (1.0f / DM); const float var = q * (1.0f / DM) - mu * mu; const float rstd = rsqrtf(var + LN_EPS);
            const f32x4 v = y4[i], gv = ((const f32x4*)p.ln2g)[c4], bv = ((const f32x4*)p.ln2b)[c4];
            yo4[i] = (v - mu) * rstd * gv + bv;
        }
    };
    PH_RUN(0, ph0) PH_RUN(1, ph1) PH_RUN(2, ph2) PH_RUN(3, ph3) PH_RUN(4, ph4) PH_RUN(5, ph5) if (!fuse_ln2) { PH_RUN(6, ph6) }
}

extern "C" void kernel_launch(void* const* d_in, const int* in_sizes, int n_in, void* d_out, int out_size, void* d_ws, size_t ws_size, hipStream_t stream) {
    static int grid_blocks = 0;
    if (!grid_blocks) {
        int dev = 0, cus = 0, per_cu = 0;
        hipGetDevice(&dev);
        hipDeviceGetAttribute(&cus, hipDeviceAttributeMultiprocessorCount, dev);
        hipOccupancyMaxActiveBlocksPerMultiprocessor(&per_cu, fwd_megakernel, 512, 0);
        if (per_cu < 1) { fprintf(stderr, "occupancy query says %d blocks/CU\n", per_cu); per_cu = 1; }
        if (per_cu > 1) per_cu = 1;
        grid_blocks = cus * per_cu;
        if (ws_size < WS_END) fprintf(stderr, "workspace too small: %zu < %zu\n", ws_size, (size_t)WS_END);
    }
    Params p{};
    p.xp = (const float*)d_in[0]; p.xs = (const float*)d_in[1]; p.ck = (const float*)d_in[2]; p.cv = (const float*)d_in[3]; p.sp = (const float*)d_in[4];
    p.w_in = (const float*)d_in[5]; p.pool_w = (const float*)d_in[6]; p.pool_scale = (const float*)d_in[7]; p.w_out = (const float*)d_in[8];
    p.ln1g = (const float*)d_in[9]; p.ln1b = (const float*)d_in[10]; p.wg = (const float*)d_in[11]; p.wu = (const float*)d_in[12]; p.wd = (const float*)d_in[13];
    p.ln2g = (const float*)d_in[14]; p.ln2b = (const float*)d_in[15];
    p.out = (float*)d_out; p.ws = (unsigned char*)d_ws;
    (void)hipMemsetAsync((unsigned char*)d_ws + WS_BAR, 0, WS_BAR_BYTES, stream);
#if MULTI_LAUNCH
    for (int ph = 0; ph < 7; ++ph) { p.ph_lo = ph; p.ph_hi = ph + 1; hipLaunchKernelGGL(fwd_megakernel, dim3(grid_blocks), dim3(512), 0, stream, p); }
#else
    p.ph_lo = 0; p.ph_hi = 7;
    void* args[] = {&p};
    hipError_t e = hipLaunchCooperativeKernel((void*)fwd_megakernel, dim3(grid_blocks), dim3(512), args, 0, stream);
    if (e != hipSuccess) fprintf(stderr, "cooperative launch failed: %s (grid %d)\n", hipGetErrorString(e), grid_blocks);
#endif
}
```
